# Optimizing an MI355X kernel written in HIP

```python
import math
import jax, jax.numpy as jnp
from jax import lax
import numpy as np

D_MODEL = 1024
BATCH = 4
SEQ = 4096
DEPTH = 2

GRID_W = 64
N_EVEN = (DEPTH + 1) // 2
N_ODD = DEPTH // 2
D_FF = 4 * D_MODEL
NORM_EPS = 1e-6

SSD_HEAD_DIM = 64
SSD_WIDTH = D_MODEL
SSD_HEADS = SSD_WIDTH // SSD_HEAD_DIM
SSD_GROUPS = 2
SSD_STATE = 128
SSD_CONV = 5
SSD_CHUNK = 128
SSD_CONV_CH = SSD_WIDTH + 2 * SSD_GROUPS * SSD_STATE

NA_HEAD_DIM = 64
NA_WIDTH = D_MODEL
NA_HEADS = NA_WIDTH // NA_HEAD_DIM
NA_KH_MAX = 8
NA_KW = 16

AB_IN = SSD_WIDTH + SSD_CONV_CH + 2 * SSD_HEADS + 3 * NA_WIDTH
AB_MIX = SSD_WIDTH + NA_WIDTH

ML_HEADS = 8
ML_DV = 2 * D_MODEL // ML_HEADS
ML_DK = ML_DV // 2
ML_CHUNK = 128
ML_WIDTH = ML_HEADS * ML_DV
ML_QK = ML_HEADS * ML_DK
ML_IN = 2 * ML_QK + 2 * ML_WIDTH + 4 * ML_HEADS

kernel_name = "hybrid_ssd_natten_mlstm_encoder"


def rmsnorm(x, g):
    xf = x.astype(jnp.float32)
    y = xf * lax.rsqrt(jnp.mean(xf * xf, axis=-1, keepdims=True) + NORM_EPS)
    return (y * g.astype(jnp.float32)).astype(x.dtype)


def modulate(h, shift, scale):
    return h * (1 + scale[:, None, :]) + shift[:, None, :]


def centred_dwconv(u, w, b):
    pad = w.shape[0] // 2
    out = lax.conv_general_dilated(u, w[:, None, :].astype(u.dtype), window_strides=(1,),
                                   padding=[(pad, pad)], dimension_numbers=('NWC', 'WIO', 'NWC'),
                                   feature_group_count=u.shape[-1])
    return out + b


def segsum(a):
    T = a.shape[-1]
    cs = jnp.cumsum(a, axis=-1)
    diff = cs[..., :, None] - cs[..., None, :]
    mask = jnp.tril(jnp.ones((T, T), dtype=bool))
    return jnp.where(mask, diff, -jnp.inf)


def ssd_scan(xh, dt, a, bm, cm):
    Bsz, L, H, P = xh.shape
    G, N = bm.shape[-2:]
    R = H // G
    T = SSD_CHUNK
    nc = L // T
    X = (xh * dt[..., None]).reshape(Bsz, nc, T, G, R, P)
    adt = (dt * a).reshape(Bsz, nc, T, G, R).transpose(0, 3, 4, 1, 2)
    Bc = bm.reshape(Bsz, nc, T, G, N)
    Cc = cm.reshape(Bsz, nc, T, G, N)
    a_cs = jnp.cumsum(adt, axis=-1)
    Lmat = jnp.exp(segsum(adt))
    cb = jnp.einsum('bctgn,bcsgn->bgcts', Cc, Bc)
    y_diag = jnp.einsum('bgrcts,bcsgrp->bctgrp', cb[:, :, None] * Lmat, X)
    decay_states = jnp.exp(a_cs[..., -1:] - a_cs)
    states = jnp.einsum('bctgn,bgrct,bctgrp->bcgrpn', Bc, decay_states, X)
    states = jnp.concatenate([jnp.zeros_like(states[:, :1]), states], axis=1)
    chunk_decay = jnp.exp(segsum(jnp.pad(a_cs[..., -1], ((0, 0), (0, 0), (0, 0), (1, 0)))))
    new_states = jnp.einsum('bgrzc,bcgrpn->bzgrpn', chunk_decay, states)
    states = new_states[:, :-1]
    y_off = jnp.einsum('bctgn,bcgrpn,bgrct->bctgrp', Cc, states, jnp.exp(a_cs))
    return (y_diag + y_off).reshape(Bsz, L, H, P)


def ssd_branch(z, xbc, dt_raw, conv_w, conv_b, dt_bias, a_log, d_skip, norm_g):
    f32 = jnp.float32
    xbc = jax.nn.silu(centred_dwconv(xbc, conv_w, conv_b)).astype(f32)
    xs, bm, cm = jnp.split(xbc, [SSD_WIDTH, SSD_WIDTH + SSD_GROUPS * SSD_STATE], axis=-1)
    Bsz, L, _ = xs.shape
    xh = xs.reshape(Bsz, L, SSD_HEADS, SSD_HEAD_DIM)
    bm = bm.reshape(Bsz, L, SSD_GROUPS, SSD_STATE)
    cm = cm.reshape(Bsz, L, SSD_GROUPS, SSD_STATE)
    dt = jax.nn.softplus(dt_raw.astype(f32).reshape(Bsz, L, 2, SSD_HEADS) + dt_bias.astype(f32))
    a = -jnp.exp(a_log.astype(f32))
    y_f = ssd_scan(xh, dt[:, :, 0], a[0], bm, cm)
    fl = lambda t: jnp.flip(t, axis=1)
    y_b = fl(ssd_scan(fl(xh), fl(dt[:, :, 1]), a[1], fl(bm), fl(cm)))
    y = y_f + y_b + d_skip.astype(f32)[:, None] * xh
    y = y.reshape(Bsz, L, SSD_WIDTH)
    return rmsnorm(y * jax.nn.silu(z.astype(f32)), norm_g)


def na_branch(qkv, rpb):
    Bsz, L, _ = qkv.shape
    rows = L // GRID_W
    kh = min(NA_KH_MAX, rows)
    q, k, v = jnp.split(qkv.astype(jnp.float32), 3, axis=-1)
    grid = lambda t: t.reshape(Bsz, rows, GRID_W, NA_HEADS, NA_HEAD_DIM)
    q = grid(q) * (NA_HEAD_DIM ** -0.5)
    k = grid(k)
    v = grid(v)
    r_idx = np.arange(rows)
    row_start = np.clip(r_idx - kh // 2, 0, rows - kh)
    c_idx = np.arange(GRID_W)
    col_start = np.clip(c_idx - NA_KW // 2, 0, GRID_W - NA_KW)
    col_keys = col_start[:, None] + np.arange(NA_KW)[None, :]
    row_off = row_start[:, None] + np.arange(kh)[None, :] - r_idx[:, None] + NA_KH_MAX - 1
    col_off = col_keys - c_idx[:, None] + NA_KW - 1
    rpb = rpb.astype(jnp.float32)

    def one_row(args):
        q_r, rs, ro = args
        k_band = lax.dynamic_slice_in_dim(k, rs, kh, axis=1)
        v_band = lax.dynamic_slice_in_dim(v, rs, kh, axis=1)
        k_win = jnp.take(k_band, col_keys, axis=2)
        v_win = jnp.take(v_band, col_keys, axis=2)
        bias = rpb[:, ro[:, None, None], col_off[None, :, :]]
        s = jnp.einsum('bwhd,biwjhd->bhwij', q_r, k_win) + bias.transpose(0, 2, 1, 3)[None]
        p = jax.nn.softmax(s.reshape(Bsz, NA_HEADS, GRID_W, kh * NA_KW), axis=-1).reshape(s.shape)
        return jnp.einsum('bhwij,biwjhd->bwhd', p, v_win)

    out = lax.map(one_row, (q.transpose(1, 0, 2, 3, 4),
                            jnp.asarray(row_start, jnp.int32), jnp.asarray(row_off, jnp.int32)))
    return out.transpose(1, 0, 2, 3, 4).reshape(Bsz, L, NA_WIDTH)


def mlstm_chunkwise(q, k, v, i_pre, f_pre):
    Bsz, H, L, DK = q.shape
    DV = v.shape[-1]
    T = ML_CHUNK
    nc = L // T
    q = q.reshape(Bsz, H, nc, T, DK)
    k = k.reshape(Bsz, H, nc, T, DK)
    v = v.reshape(Bsz, H, nc, T, DV)
    ig = i_pre.reshape(Bsz, H, nc, T)
    b = jnp.cumsum(jax.nn.log_sigmoid(f_pre).reshape(Bsz, H, nc, T), axis=-1)
    g = b[..., -1]
    a = g[..., None] - b + ig
    m_loc = jnp.max(a, axis=-1)
    w = jnp.exp(a - m_loc[..., None])
    S_loc = jnp.einsum('bhct,bhctk,bhctv->bhckv', w, k, v)
    n_loc = jnp.einsum('bhct,bhctk->bhck', w, k)

    def step(carry, inp):
        C, n, m = carry
        S_c, n_c, m_c, g_c = inp
        m_new = jnp.maximum(g_c + m, m_c)
        s_old = jnp.exp(g_c + m - m_new)
        s_new = jnp.exp(m_c - m_new)
        C_new = s_old[..., None, None] * C + s_new[..., None, None] * S_c
        n_new = s_old[..., None] * n + s_new[..., None] * n_c
        return (C_new, n_new, m_new), (C, n, m)

    init = (jnp.zeros((Bsz, H, DK, DV), jnp.float32), jnp.zeros((Bsz, H, DK), jnp.float32),
            jnp.zeros((Bsz, H), jnp.float32))
    mv = lambda t: jnp.moveaxis(t, 2, 0)
    _, (C_prev, n_prev, m_prev) = lax.scan(step, init, (mv(S_loc), mv(n_loc), mv(m_loc), mv(g)))
    C_prev = jnp.moveaxis(C_prev, 0, 2)
    n_prev = jnp.moveaxis(n_prev, 0, 2)
    m_prev = jnp.moveaxis(m_prev, 0, 2)
    mask = jnp.tril(jnp.ones((T, T), dtype=bool))
    Dm = jnp.where(mask, b[..., :, None] - b[..., None, :] + ig[..., None, :], -jnp.inf)
    m_inter = b + m_prev[..., None]
    m_t = jnp.maximum(m_inter, jnp.max(Dm, axis=-1))
    sc = jnp.einsum('bhctk,bhcsk->bhcts', q, k) * jnp.exp(Dm - m_t[..., None])
    inter_scale = jnp.exp(m_inter - m_t)
    num = jnp.einsum('bhcts,bhcsv->bhctv', sc, v) + inter_scale[..., None] * jnp.einsum('bhctk,bhckv->bhctv', q, C_prev)
    den = jnp.sum(sc, axis=-1) + inter_scale * jnp.einsum('bhctk,bhck->bhct', q, n_prev)
    h = num / jnp.maximum(jnp.abs(den), jnp.exp(-m_t))[..., None]
    return h.reshape(Bsz, H, L, DV)


def mlstm_branch(proj, gate_b, head_g):
    Bsz, L, _ = proj.shape
    q, k, v, o, gates = jnp.split(proj.astype(jnp.float32),
                                  [ML_QK, 2 * ML_QK, 2 * ML_QK + ML_WIDTH, 2 * ML_QK + 2 * ML_WIDTH], axis=-1)
    heads = lambda t, d: t.reshape(Bsz, L, ML_HEADS, d).transpose(0, 2, 1, 3)
    q = heads(q, ML_DK) * (ML_DK ** -0.5)
    k = heads(k, ML_DK)
    v = heads(v, ML_DV)
    gates = (gates.reshape(Bsz, L, 4, ML_HEADS) + gate_b.astype(jnp.float32)).transpose(0, 2, 3, 1)
    h_f = mlstm_chunkwise(q, k, v, gates[:, 0], gates[:, 1])
    fl = lambda t: jnp.flip(t, axis=2)
    h_b = fl(mlstm_chunkwise(fl(q), fl(k), fl(v), fl(gates[:, 2]), fl(gates[:, 3])))
    h = (h_f + h_b).transpose(0, 2, 1, 3)
    h = rmsnorm(h, head_g.reshape(ML_HEADS, ML_DV))
    return jax.nn.sigmoid(o) * h.reshape(Bsz, L, ML_WIDTH)


def ssd_na_mixer(h, w_in, conv_w, conv_b, dt_bias, a_log, d_skip, ssd_norm, rpb, w_out):
    proj = h @ w_in
    s1 = SSD_WIDTH
    s2 = s1 + SSD_CONV_CH
    s3 = s2 + 2 * SSD_HEADS
    z, xbc, dt_raw, qkv = jnp.split(proj, [s1, s2, s3], axis=-1)
    y_ssd = ssd_branch(z, xbc, dt_raw, conv_w, conv_b, dt_bias, a_log, d_skip, ssd_norm)
    y_na = na_branch(qkv, rpb)
    y = jnp.concatenate([y_ssd.astype(jnp.float32), y_na], axis=-1)
    return y.astype(h.dtype) @ w_out


def mlstm_mixer(h, w_in, gate_b, head_g, w_out):
    y = mlstm_branch(h @ w_in, gate_b, head_g)
    return y.astype(h.dtype) @ w_out


def setup_inputs(seed: int = 0) -> dict:
    key = jax.random.key(seed)
    ks = jax.random.split(key, 20)
    nrm = lambda k, shape, s: jax.random.normal(k, shape, jnp.float32) * s
    x = nrm(ks[0], (BATCH, SEQ, D_MODEL), 1.0)
    c = nrm(ks[1], (BATCH, D_MODEL), 1.0)
    ada_w = nrm(ks[2], (DEPTH, D_MODEL, 6 * D_MODEL), 0.5 * D_MODEL ** -0.5)
    ada_b = nrm(ks[3], (DEPTH, 6 * D_MODEL), 0.02)
    norm_g = 1.0 + nrm(ks[4], (DEPTH, 4, D_MODEL), 0.02)
    mlp_w1 = nrm(ks[5], (DEPTH, D_MODEL, D_FF), D_MODEL ** -0.5)
    mlp_w2 = nrm(ks[6], (DEPTH, D_FF, D_MODEL), D_FF ** -0.5)
    ab_w_in = nrm(ks[7], (N_EVEN, D_MODEL, AB_IN), D_MODEL ** -0.5)
    ab_conv_w = nrm(ks[8], (N_EVEN, SSD_CONV, SSD_CONV_CH), SSD_CONV ** -0.5)
    ab_conv_b = nrm(ks[9], (N_EVEN, SSD_CONV_CH), 0.02)
    dt0 = jnp.exp(jax.random.uniform(ks[10], (N_EVEN, 2, SSD_HEADS), jnp.float32,
                                     minval=math.log(1e-3), maxval=math.log(1e-1)))
    ab_dt_bias = dt0 + jnp.log(-jnp.expm1(-dt0))
    ab_a_log = jnp.log(jax.random.uniform(ks[11], (N_EVEN, 2, SSD_HEADS), jnp.float32, minval=1.0, maxval=16.0))
    ab_d_skip = 1.0 + nrm(ks[12], (N_EVEN, SSD_HEADS), 0.02)
    ab_ssd_norm = 1.0 + nrm(ks[13], (N_EVEN, SSD_WIDTH), 0.02)
    ab_rpb = nrm(ks[14], (N_EVEN, NA_HEADS, 2 * NA_KH_MAX - 1, 2 * NA_KW - 1), 0.1)
    ab_w_out = nrm(ks[15], (N_EVEN, AB_MIX, D_MODEL), AB_MIX ** -0.5)
    ml_w_in = nrm(ks[16], (N_ODD, D_MODEL, ML_IN), D_MODEL ** -0.5)
    gate_base = jnp.array([0.0, 4.0, 0.0, 4.0], jnp.float32)[None, :, None]
    ml_gate_b = gate_base + nrm(ks[17], (N_ODD, 4, ML_HEADS), 0.1)
    ml_head_norm = 1.0 + nrm(ks[18], (N_ODD, ML_WIDTH), 0.02)
    ml_w_out = nrm(ks[19], (N_ODD, ML_WIDTH, D_MODEL), ML_WIDTH ** -0.5)
    return {"x": x, "c": c, "ada_w": ada_w, "ada_b": ada_b, "norm_g": norm_g,
            "mlp_w1": mlp_w1, "mlp_w2": mlp_w2,
            "ab_w_in": ab_w_in, "ab_conv_w": ab_conv_w, "ab_conv_b": ab_conv_b,
            "ab_dt_bias": ab_dt_bias, "ab_a_log": ab_a_log, "ab_d_skip": ab_d_skip,
            "ab_ssd_norm": ab_ssd_norm, "ab_rpb": ab_rpb, "ab_w_out": ab_w_out,
            "ml_w_in": ml_w_in, "ml_gate_b": ml_gate_b, "ml_head_norm": ml_head_norm, "ml_w_out": ml_w_out}


def reference(x, c, ada_w, ada_b, norm_g, mlp_w1, mlp_w2,
              ab_w_in, ab_conv_w, ab_conv_b, ab_dt_bias, ab_a_log, ab_d_skip, ab_ssd_norm, ab_rpb, ab_w_out,
              ml_w_in, ml_gate_b, ml_head_norm, ml_w_out):
    cond = jax.nn.silu(c)
    for layer in range(DEPTH):
        mod = cond @ ada_w[layer] + ada_b[layer]
        sh1, sc1, g1, sh2, sc2, g2 = jnp.split(mod, 6, axis=-1)
        h = modulate(rmsnorm(x, norm_g[layer, 0]), sh1, sc1)
        if layer % 2 == 0:
            j = layer // 2
            mixed = ssd_na_mixer(h, ab_w_in[j], ab_conv_w[j], ab_conv_b[j], ab_dt_bias[j], ab_a_log[j],
                                 ab_d_skip[j], ab_ssd_norm[j], ab_rpb[j], ab_w_out[j])
        else:
            j = layer // 2
            mixed = mlstm_mixer(h, ml_w_in[j], ml_gate_b[j], ml_head_norm[j], ml_w_out[j])
        x = x + g1[:, None, :] * rmsnorm(mixed, norm_g[layer, 1])
        h = modulate(rmsnorm(x, norm_g[layer, 2]), sh2, sc2)
        u = jnp.square(jax.nn.relu(h @ mlp_w1[layer])) @ mlp_w2[layer]
        x = x + g2[:, None, :] * rmsnorm(u, norm_g[layer, 3])
    return x
```

```cpp
#include <hip/hip_runtime.h>
#include <cstdio>
#include <cstdint>

#define GAS __attribute__((address_space(1)))
#define LAS __attribute__((address_space(3)))
typedef unsigned short bf16;
typedef short bf16x8 __attribute__((ext_vector_type(8)));
typedef float f32x4 __attribute__((ext_vector_type(4)));
typedef unsigned u32x4 __attribute__((ext_vector_type(4)));
typedef unsigned u32x2 __attribute__((ext_vector_type(2)));

#ifndef MK_ONE_LAUNCH
#define MK_ONE_LAUNCH 0
#endif

constexpr int NWAVES = 8, NTHREADS = 512;
constexpr int BATCH = 4, SEQ = 4096, DM = 1024, M = BATCH * SEQ, FF = 4096;
constexpr float EPS = 1e-6f;
constexpr int SH = 16, SP = 64, SN = 128, CONVCH = 1536, ABIN = 5664;
constexpr int LDP0 = 5632, P0_Z = 0, P0_Q = 1024, P0_K = 2048, P0_V = 3072, P0_XBC = 4096;
constexpr int MH = 8, MDK = 128, MDV = 256, MLIN = 6176, LDP1 = 4096, P1_Q = 0, P1_K = 1024, P1_V = 2048;
constexpr int NPHASE = 21;

constexpr size_t MiB = 1u << 20;
constexpr size_t WS_CTL = 0, CTL_ZERO_BYTES = 1 * MiB;
constexpr size_t WS_MOD = 1 * MiB;
constexpr size_t W0_IN = 2 * MiB, W0_DT = 13 * MiB, W0_OUT = 14 * MiB, W0_W1 = 18 * MiB, W0_W2 = 26 * MiB;
constexpr size_t WS0_XN = 36 * MiB, WS0_DT = 68 * MiB, WS0_PROJ = 70 * MiB, WS0_U = 70 * MiB, WS0_MLPOUT = 198 * MiB;
constexpr size_t W1_QKV = 2 * MiB, W1_O = 10 * MiB, W1_G = 14 * MiB, W1_OUT = 15 * MiB, W1_W1 = 2 * MiB, W1_W2 = 10 * MiB;
constexpr size_t WS1_GATES = 19 * MiB, WS1_XN = 21 * MiB, WS1_PROJ = 53 * MiB, WS1_H = 181 * MiB, WS1_RS = 245 * MiB;
constexpr size_t WS1_MIX = 53 * MiB, WS1_U = 53 * MiB, WS1_MLPOUT = 181 * MiB;
constexpr size_t WS_END = 256 * MiB;
constexpr size_t DO_XBC = 0;

constexpr int LDS_BYTES = 147456;

__device__ __forceinline__ float bf2f(unsigned v) { return __uint_as_float(v << 16); }
__device__ __forceinline__ unsigned f2bf(float f) { unsigned u = __float_as_uint(f); return (u + 0x7fffu + ((u >> 16) & 1u)) >> 16; }
__device__ __forceinline__ unsigned pk2(float lo, float hi) { return f2bf(lo) | (f2bf(hi) << 16); }
__device__ __forceinline__ float bflo(unsigned w) { return __uint_as_float(w << 16); }
__device__ __forceinline__ float bfhi(unsigned w) { return __uint_as_float(w & 0xffff0000u); }
__device__ __forceinline__ float wave_sum(float v) {
#pragma unroll
    for (int o = 1; o < 64; o <<= 1) v += __shfl_xor(v, o);
    return v;
}
__device__ __forceinline__ float silu_f(float x) { return x / (1.f + __expf(-x)); }
__device__ __forceinline__ float sigmoid_f(float x) { return 1.f / (1.f + __expf(-x)); }
__device__ __forceinline__ float softplus_f(float x) { return x > 20.f ? x : log1pf(__expf(x)); }

#define XB_TMO      128
#define XB_XCNT(j)  (256  + 64 * (j))
#define XB_XSUB(j)  (1280 + 64 * (j))
#define XB_XGEN(j)  (2304 + 64 * (j))
#define XB_TOP      3328
#define XB_TOPGEN   3392
#define XCD_BAR_WORDS 3456
#define XB_SPIN_CAP (1u << 22)
__device__ __forceinline__ unsigned xb_ld(unsigned* p)              { return __hip_atomic_load(p, __ATOMIC_RELAXED, __HIP_MEMORY_SCOPE_AGENT); }
__device__ __forceinline__ unsigned xb_add(unsigned* p, unsigned v) { return __hip_atomic_fetch_add(p, v, __ATOMIC_RELAXED, __HIP_MEMORY_SCOPE_AGENT); }
__device__ __forceinline__ unsigned xb_xcc_id() { return (unsigned)__builtin_amdgcn_s_getreg((3 << 11) | 20) & 0xFu; }
#define XB_SPIN(cond, bar) do { unsigned _sp = 0; while (cond) { __builtin_amdgcn_s_sleep(1); \
    if ((++_sp & 255u) == 0u) { if (xb_ld(&(bar)[XB_TMO])) break; if (_sp > XB_SPIN_CAP) { atomicAdd(&(bar)[XB_TMO], 1u); break; } } } } while (0)
struct XcdBarrier { unsigned* bar; unsigned x; volatile LAS unsigned* st; };
__device__ __forceinline__ XcdBarrier xcd_barrier_post(unsigned* bar, volatile LAS unsigned* st) {
    XcdBarrier b; b.bar = bar; b.x = xb_xcc_id(); b.st = st;
    if (threadIdx.x == 0) (void)xb_add(&bar[XB_XCNT(b.x)], 1u);
    return b;
}
__device__ __forceinline__ void xcd_barrier_complete(unsigned* bar, unsigned x, unsigned& nloc, unsigned& nx) {
    const unsigned G = gridDim.x * gridDim.y * gridDim.z;
    unsigned sum, cnt, mine, sp = 0u;
    for (;;) {
        sum = 0u; cnt = 0u; mine = 0u;
#pragma unroll
        for (unsigned j = 0; j < 16; ++j) { const unsigned c = xb_ld(&bar[XB_XCNT(j)]); sum += c; cnt += (c > 0u) ? 1u : 0u; mine = (j == x) ? c : mine; }
        if (sum == G) break;
        __builtin_amdgcn_s_sleep(1);
        if ((++sp & 255u) == 0u) { if (xb_ld(&bar[XB_TMO])) break; if (sp > XB_SPIN_CAP) { atomicAdd(&bar[XB_TMO], 1u); break; } }
    }
    nloc = mine > 0u ? mine : 1u; nx = cnt > 0u ? cnt : 1u;
}
__device__ __forceinline__ void xcd_barrier(const XcdBarrier& b) {
    asm volatile("s_waitcnt vmcnt(0)" ::: "memory");
    __syncthreads();
    if (threadIdx.x == 0) {
        unsigned* bar = b.bar;
        __builtin_amdgcn_s_waitcnt(0);
        unsigned nloc = b.st[0], nx = b.st[1];
        if (nloc == 0u) { xcd_barrier_complete(bar, b.x, nloc, nx); b.st[0] = nloc; b.st[1] = nx; }
        const unsigned old = xb_add(&bar[XB_XSUB(b.x)], 1u);
        const unsigned gen = old / nloc;
        if (old + 1u == (gen + 1u) * nloc) {
            __builtin_amdgcn_fence(__ATOMIC_RELEASE, "agent");
            asm volatile("s_waitcnt vmcnt(0)" ::: "memory");
            const unsigned og = xb_add(&bar[XB_TOP], 1u);
            const unsigned tg = og / nx;
            if (og + 1u == (tg + 1u) * nx) xb_add(&bar[XB_TOPGEN], 1u);
            else XB_SPIN(xb_ld(&bar[XB_TOPGEN]) == tg, bar);
            __builtin_amdgcn_fence(__ATOMIC_ACQUIRE, "agent");
            xb_add(&bar[XB_XGEN(b.x)], 1u);
            asm volatile("s_waitcnt vmcnt(0)" ::: "memory");
        } else {
            XB_SPIN(xb_ld(&bar[XB_XGEN(b.x)]) == gen, bar);
            __builtin_amdgcn_fence(__ATOMIC_ACQUIRE, "agent");
            asm volatile("s_waitcnt vmcnt(0)" ::: "memory");
        }
    }
    __syncthreads();
}

struct Args { const float* in[20]; float* out; unsigned char* ws; int ph_lo, ph_hi; };
struct Frame {
    LAS unsigned char* lds;
    int tid, lane, wave, G, vcu;
    const float *x, *c, *ada_w, *ada_b, *norm_g, *mlp_w1, *mlp_w2, *ab_w_in, *conv_w, *conv_b, *dt_bias, *a_log, *d_skip, *ssd_norm, *rpb, *ab_w_out,
                *ml_w_in, *gate_b, *head_norm, *ml_w_out;
    float* out; unsigned char* ws;
};

__device__ __forceinline__ void transpose_item(const float* W, int K, int ldw, int c0, int ncols, bf16* WT, LAS float* scr, int item, int lane) {
    const int nblk = ncols / 32, kb = item / nblk, nb = item % nblk, k0 = 64 * kb, n0 = 32 * nb;
#pragma unroll 8
    for (int i = 0; i < 32; ++i) { const int kk = 2 * i + (lane >> 5); scr[kk * 33 + (lane & 31)] = W[(size_t)(k0 + kk) * ldw + c0 + n0 + (lane & 31)]; }
    asm volatile("s_waitcnt lgkmcnt(0)" ::: "memory");
    const int c = lane & 7;
#pragma unroll
    for (int j = 0; j < 4; ++j) { const int n = (lane >> 3) + 8 * j; const LAS float* s = scr + (8 * c) * 33 + n;
        u32x4 o; o.x = pk2(s[0 * 33], s[1 * 33]); o.y = pk2(s[2 * 33], s[3 * 33]); o.z = pk2(s[4 * 33], s[5 * 33]); o.w = pk2(s[6 * 33], s[7 * 33]);
        *(u32x4*)(WT + (size_t)(n0 + n) * K + k0 + 8 * c) = o; }
    asm volatile("s_waitcnt lgkmcnt(0)" ::: "memory");
}
struct TrJob { const float* W; int K, ldw, c0, ncols; bf16* WT; };
template <int NJ> __device__ __forceinline__ void transpose_jobs(Frame& F, const TrJob (&jobs)[NJ]) {
    LAS float* scr = (LAS float*)(F.lds + F.wave * 16384);
    const int gw = F.vcu * NWAVES + F.wave, NGW = F.G * NWAVES;
    int base = 0;
#pragma unroll
    for (int j = 0; j < NJ; ++j) {
        const int nitems = (jobs[j].K / 64) * (jobs[j].ncols / 32);
        int first = gw - (base % NGW); if (first < 0) first += NGW;
        for (int it = first; it < nitems; it += NGW) transpose_item(jobs[j].W, jobs[j].K, jobs[j].ldw, jobs[j].c0, jobs[j].ncols, jobs[j].WT, scr, it, F.lane);
        base += nitems;
    }
}

__device__ __forceinline__ void mod_phase(Frame& F) {
    float* mod = (float*)(F.ws + WS_MOD);
    LAS float* red = (LAS float*)F.lds;
    for (int item = blockIdx.x; item < 2 * 96; item += F.G) {
        const int l = item / 96, cg = item % 96, col = cg * 64 + F.lane, kg = F.wave;
        float acc0 = 0.f, acc1 = 0.f, acc2 = 0.f, acc3 = 0.f;
        const float* w = F.ada_w + ((size_t)l * 1024 + kg * 128) * 6144 + col;
        const float* cc = F.c + kg * 128;
#pragma unroll 4
        for (int k = 0; k < 128; ++k) {
            const float wv = w[(size_t)k * 6144];
            acc0 += silu_f(cc[k]) * wv; acc1 += silu_f(cc[1024 + k]) * wv; acc2 += silu_f(cc[2048 + k]) * wv; acc3 += silu_f(cc[3072 + k]) * wv;
        }
        red[(kg * 4 + 0) * 64 + F.lane] = acc0; red[(kg * 4 + 1) * 64 + F.lane] = acc1; red[(kg * 4 + 2) * 64 + F.lane] = acc2; red[(kg * 4 + 3) * 64 + F.lane] = acc3;
        __syncthreads();
        if (F.tid < 256) { const int b = F.tid >> 6, ln = F.tid & 63; float s = 0.f;
#pragma unroll
            for (int g = 0; g < 8; ++g) s += red[(g * 4 + b) * 64 + ln];
            mod[((size_t)l * 4 + b) * 6144 + cg * 64 + ln] = s + F.ada_b[l * 6144 + cg * 64 + ln]; }
        __syncthreads();
    }
}

template <bool HAS_MIX, bool HAS_XN>
__device__ __forceinline__ void rowpass(Frame& F, const float* xin, const bf16* mix, const float* gate, const float* ng_mix, float* xout,
                                        const float* ng_x, const float* sh, const float* sc, bf16* xn) {
    const int gw = F.vcu * NWAVES + F.wave, NGW = F.G * NWAVES;
    for (int m = gw; m < M; m += NGW) {
        const int b = m / SEQ;
        f32x4 v[4];
#pragma unroll
        for (int j = 0; j < 4; ++j) v[j] = *(const f32x4*)(xin + (size_t)m * DM + 4 * F.lane + 256 * j);
        if (HAS_MIX) {
            f32x4 mv[4]; float ss = 0.f;
#pragma unroll
            for (int j = 0; j < 4; ++j) { const u32x2 w = *(const u32x2*)(mix + (size_t)m * DM + 4 * F.lane + 256 * j);
                mv[j] = (f32x4){bflo(w.x), bfhi(w.x), bflo(w.y), bfhi(w.y)}; ss += (mv[j].x * mv[j].x + mv[j].y * mv[j].y) + (mv[j].z * mv[j].z + mv[j].w * mv[j].w); }
            const float rstd = rsqrtf(wave_sum(ss) * (1.f / DM) + EPS);
#pragma unroll
            for (int j = 0; j < 4; ++j) { const int c = 4 * F.lane + 256 * j; const f32x4 g = *(const f32x4*)(gate + (size_t)b * 6144 + c), ng = *(const f32x4*)(ng_mix + c);
                v[j] = v[j] + g * (mv[j] * rstd * ng); *(f32x4*)(xout + (size_t)m * DM + c) = v[j]; }
        }
        if (HAS_XN) {
            float ss = 0.f;
#pragma unroll
            for (int j = 0; j < 4; ++j) ss += (v[j].x * v[j].x + v[j].y * v[j].y) + (v[j].z * v[j].z + v[j].w * v[j].w);
            const float rstd = rsqrtf(wave_sum(ss) * (1.f / DM) + EPS);
#pragma unroll
            for (int j = 0; j < 4; ++j) { const int c = 4 * F.lane + 256 * j; const f32x4 ng = *(const f32x4*)(ng_x + c), s1 = *(const f32x4*)(sc + (size_t)b * 6144 + c), s0 = *(const f32x4*)(sh + (size_t)b * 6144 + c);
                const f32x4 o = (v[j] * rstd * ng) * (s1 + 1.f) + s0; u32x2 w; w.x = pk2(o.x, o.y); w.y = pk2(o.z, o.w);
                *(u32x2*)(xn + (size_t)m * DM + c) = w; }
        }
    }
}

template <class Epi>
__device__ __forceinline__ void gemm_simple(Frame& F, const bf16* A, int lda, const bf16* Bt, int Mr, int N, int K, const Epi& E) {
    const int gw = F.vcu * NWAVES + F.wave, NGW = F.G * NWAVES;
    const int tn_n = N / 32, ntiles = (Mr / 32) * tn_n;
    const int fr = F.lane & 15, fq = F.lane >> 4;
    for (int t = gw; t < ntiles; t += NGW) {
        const int tm = t / tn_n, tn = t % tn_n, m0 = tm * 32, n0 = tn * 32;
        f32x4 acc[2][2];
#pragma unroll
        for (int i = 0; i < 2; ++i)
#pragma unroll
            for (int j = 0; j < 2; ++j) acc[i][j] = (f32x4){0.f, 0.f, 0.f, 0.f};
        const bf16* ap = A + (size_t)(m0 + fr) * lda + fq * 8;
        const bf16* bp = Bt + (size_t)(n0 + fr) * K + fq * 8;
#pragma unroll 2
        for (int k0 = 0; k0 < K; k0 += 32) {
            const bf16x8 a0 = *(const bf16x8*)(ap + k0), a1 = *(const bf16x8*)(ap + (size_t)16 * lda + k0);
            const bf16x8 b0 = *(const bf16x8*)(bp + k0), b1 = *(const bf16x8*)(bp + (size_t)16 * K + k0);
            acc[0][0] = __builtin_amdgcn_mfma_f32_16x16x32_bf16(b0, a0, acc[0][0], 0, 0, 0);
            acc[0][1] = __builtin_amdgcn_mfma_f32_16x16x32_bf16(b1, a0, acc[0][1], 0, 0, 0);
            acc[1][0] = __builtin_amdgcn_mfma_f32_16x16x32_bf16(b0, a1, acc[1][0], 0, 0, 0);
            acc[1][1] = __builtin_amdgcn_mfma_f32_16x16x32_bf16(b1, a1, acc[1][1], 0, 0, 0);
        }
#pragma unroll
        for (int i = 0; i < 2; ++i)
#pragma unroll
            for (int j = 0; j < 2; ++j) E.put4(m0 + 16 * i + fr, n0 + 16 * j + 4 * fq, acc[i][j]);
    }
}
struct EpiBf16 {
    bf16* O; int ldc; int scale_cols; float scale;
    __device__ __forceinline__ void put4(int row, int col, f32x4 v) const {
        if (col < scale_cols) v = v * scale;
        u32x2 w; w.x = pk2(v.x, v.y); w.y = pk2(v.z, v.w); *(u32x2*)(O + (size_t)row * ldc + col) = w; }
};
struct EpiRelu2 {
    bf16* O; int ldc;
    __device__ __forceinline__ void put4(int row, int col, f32x4 v) const {
        v.x = fmaxf(v.x, 0.f); v.y = fmaxf(v.y, 0.f); v.z = fmaxf(v.z, 0.f); v.w = fmaxf(v.w, 0.f); v = v * v;
        u32x2 w; w.x = pk2(v.x, v.y); w.y = pk2(v.z, v.w); *(u32x2*)(O + (size_t)row * ldc + col) = w; }
};
struct EpiDt {
    float* O; const float* bias;
    __device__ __forceinline__ void put4(int row, int col, f32x4 v) const {
        const f32x4 b = *(const f32x4*)(bias + col); f32x4 o;
        o.x = softplus_f(v.x + b.x); o.y = softplus_f(v.y + b.y); o.z = softplus_f(v.z + b.z); o.w = softplus_f(v.w + b.w);
        *(f32x4*)(O + (size_t)row * 32 + col) = o; }
};
struct EpiGates {
    float* O; const float* bias;
    __device__ __forceinline__ void put4(int row, int col, f32x4 v) const { *(f32x4*)(O + (size_t)row * 32 + col) = v + *(const f32x4*)(bias + col); }
};
struct EpiOGate {
    bf16* H; const float* RS; const float* hg;
    __device__ __forceinline__ void put4(int row, int col, f32x4 v) const {
        bf16* p = H + (size_t)row * 2048 + col; const u32x2 w = *(const u32x2*)p; const float rs = RS[(size_t)row * 8 + (col >> 8)]; const f32x4 g = *(const f32x4*)(hg + col);
        f32x4 o; o.x = sigmoid_f(v.x) * bflo(w.x) * rs * g.x; o.y = sigmoid_f(v.y) * bfhi(w.x) * rs * g.y; o.z = sigmoid_f(v.z) * bflo(w.y) * rs * g.z; o.w = sigmoid_f(v.w) * bfhi(w.y) * rs * g.w;
        u32x2 r; r.x = pk2(o.x, o.y); r.y = pk2(o.z, o.w); *(u32x2*)p = r; }
};

__device__ __forceinline__ void conv_phase(Frame& F) {
    const bf16* proj = (const bf16*)(F.ws + WS0_PROJ);
    bf16* xbcp = (bf16*)((unsigned char*)F.out + DO_XBC);
    const size_t total = (size_t)M * (CONVCH / 8), stride = (size_t)F.G * NTHREADS;
    for (size_t i = (size_t)blockIdx.x * NTHREADS + F.tid; i < total; i += stride) {
        const int row = (int)(i / (CONVCH / 8)), cg = (int)(i % (CONVCH / 8)), c0 = cg * 8, t = row % SEQ;
        float acc[8];
#pragma unroll
        for (int e = 0; e < 8; ++e) acc[e] = F.conv_b[c0 + e];
#pragma unroll
        for (int j = 0; j < 5; ++j) {
            const int tt = t + j - 2;
            if (tt >= 0 && tt < SEQ) {
                const u32x4 w = *(const u32x4*)(proj + (size_t)(row + j - 2) * LDP0 + P0_XBC + c0);
                const f32x4 k0 = *(const f32x4*)(F.conv_w + j * CONVCH + c0), k1 = *(const f32x4*)(F.conv_w + j * CONVCH + c0 + 4);
                acc[0] += bflo(w.x) * k0.x; acc[1] += bfhi(w.x) * k0.y; acc[2] += bflo(w.y) * k0.z; acc[3] += bfhi(w.y) * k0.w;
                acc[4] += bflo(w.z) * k1.x; acc[5] += bfhi(w.z) * k1.y; acc[6] += bflo(w.w) * k1.z; acc[7] += bfhi(w.w) * k1.w;
            }
        }
        u32x4 o; o.x = pk2(silu_f(acc[0]), silu_f(acc[1])); o.y = pk2(silu_f(acc[2]), silu_f(acc[3])); o.z = pk2(silu_f(acc[4]), silu_f(acc[5])); o.w = pk2(silu_f(acc[6]), silu_f(acc[7]));
        *(u32x4*)(xbcp + (size_t)row * CONVCH + c0) = o;
    }
}

__device__ __forceinline__ void ssd_simple_item(Frame& F, int item) {
    const int dir = item >> 6, b = (item >> 4) & 3, h = item & 15, g = h >> 3;
    const int p = F.tid >> 3, nq = F.tid & 7;
    const float a = -__expf(F.a_log[dir * 16 + h]);
    const bf16* xbc = (const bf16*)((unsigned char*)F.out + DO_XBC);
    const float* dtv = (const float*)(F.ws + WS0_DT);
    bf16* Y; int ldy;
    if (dir == 0) { Y = (bf16*)(F.ws + WS0_PROJ) + P0_XBC; ldy = LDP0; } else { Y = (bf16*)(F.ws + WS0_XN); ldy = DM; }
    float S[16];
#pragma unroll
    for (int j = 0; j < 16; ++j) S[j] = 0.f;
    for (int tt = 0; tt < SEQ; ++tt) {
        const int tok = dir ? SEQ - 1 - tt : tt; const size_t row = (size_t)b * SEQ + tok;
        const float dt = dtv[row * 32 + dir * 16 + h];
        const float dA = __expf(dt * a);
        const float xv = bf2f(xbc[row * CONVCH + h * 64 + p]) * dt;
        const u32x4* Bp = (const u32x4*)(xbc + row * CONVCH + 1024 + g * 128 + nq * 16); const u32x4 b0 = Bp[0], b1 = Bp[1];
        const u32x4* Cp = (const u32x4*)(xbc + row * CONVCH + 1280 + g * 128 + nq * 16); const u32x4 c0 = Cp[0], c1 = Cp[1];
        const float Bv[16] = {bflo(b0.x), bfhi(b0.x), bflo(b0.y), bfhi(b0.y), bflo(b0.z), bfhi(b0.z), bflo(b0.w), bfhi(b0.w), bflo(b1.x), bfhi(b1.x), bflo(b1.y), bfhi(b1.y), bflo(b1.z), bfhi(b1.z), bflo(b1.w), bfhi(b1.w)};
        const float Cv[16] = {bflo(c0.x), bfhi(c0.x), bflo(c0.y), bfhi(c0.y), bflo(c0.z), bfhi(c0.z), bflo(c0.w), bfhi(c0.w), bflo(c1.x), bfhi(c1.x), bflo(c1.y), bfhi(c1.y), bflo(c1.z), bfhi(c1.z), bflo(c1.w), bfhi(c1.w)};
        float acc = 0.f;
#pragma unroll
        for (int j = 0; j < 16; ++j) { S[j] = dA * S[j] + xv * Bv[j]; acc += Cv[j] * S[j]; }
        acc += __shfl_xor(acc, 1); acc += __shfl_xor(acc, 2); acc += __shfl_xor(acc, 4);
        if (nq == 0) Y[row * ldy + h * 64 + p] = (bf16)f2bf(acc);
    }
}

__device__ __forceinline__ float dot64(const bf16* kp, const float (&q)[64]) {
    float s = 0.f;
#pragma unroll
    for (int c = 0; c < 8; ++c) { const u32x4 w = *(const u32x4*)(kp + 8 * c);
        s += q[8 * c] * bflo(w.x) + q[8 * c + 1] * bfhi(w.x) + q[8 * c + 2] * bflo(w.y) + q[8 * c + 3] * bfhi(w.y) + q[8 * c + 4] * bflo(w.z) + q[8 * c + 5] * bfhi(w.z) + q[8 * c + 6] * bflo(w.w) + q[8 * c + 7] * bfhi(w.w); }
    return s;
}
__device__ __forceinline__ void na_simple(Frame& F, int blk, int nblk) {
    bf16* proj = (bf16*)(F.ws + WS0_PROJ);
    const size_t total = (size_t)M * 16, stride = (size_t)nblk * NTHREADS;
    for (size_t i = (size_t)blk * NTHREADS + F.tid; i < total; i += stride) {
        const int row = (int)(i >> 4), h = (int)(i & 15), b = row / SEQ, t = row % SEQ, r = t >> 6, w = t & 63;
        int rs = r - 4; rs = rs < 0 ? 0 : (rs > 56 ? 56 : rs);
        int cs = w - 8; cs = cs < 0 ? 0 : (cs > 48 ? 48 : cs);
        float q[64];
        {
            const bf16* qp = proj + (size_t)row * LDP0 + P0_Q + h * 64;
#pragma unroll
            for (int c = 0; c < 8; ++c) { const u32x4 v = *(const u32x4*)(qp + 8 * c);
                q[8 * c] = bflo(v.x); q[8 * c + 1] = bfhi(v.x); q[8 * c + 2] = bflo(v.y); q[8 * c + 3] = bfhi(v.y); q[8 * c + 4] = bflo(v.z); q[8 * c + 5] = bfhi(v.z); q[8 * c + 6] = bflo(v.w); q[8 * c + 7] = bfhi(v.w); }
        }
        const float* rp = F.rpb + (size_t)h * 15 * 31;
        float mx = -1e30f;
        for (int ii = 0; ii < 8; ++ii) for (int jj = 0; jj < 16; ++jj) {
            const int kr = rs + ii, kc = cs + jj; const size_t krow = (size_t)b * SEQ + kr * 64 + kc;
            const float s = dot64(proj + krow * LDP0 + P0_K + h * 64, q) + rp[(kr - r + 7) * 31 + (kc - w + 15)];
            mx = fmaxf(mx, s);
        }
        float o[64]; float l = 0.f;
#pragma unroll
        for (int d = 0; d < 64; ++d) o[d] = 0.f;
        for (int ii = 0; ii < 8; ++ii) for (int jj = 0; jj < 16; ++jj) {
            const int kr = rs + ii, kc = cs + jj; const size_t krow = (size_t)b * SEQ + kr * 64 + kc;
            const float s = dot64(proj + krow * LDP0 + P0_K + h * 64, q) + rp[(kr - r + 7) * 31 + (kc - w + 15)];
            const float pr = __expf(s - mx); l += pr;
            const bf16* vp = proj + krow * LDP0 + P0_V + h * 64;
#pragma unroll
            for (int c = 0; c < 8; ++c) { const u32x4 v = *(const u32x4*)(vp + 8 * c);
                o[8 * c] += pr * bflo(v.x); o[8 * c + 1] += pr * bfhi(v.x); o[8 * c + 2] += pr * bflo(v.y); o[8 * c + 3] += pr * bfhi(v.y);
                o[8 * c + 4] += pr * bflo(v.z); o[8 * c + 5] += pr * bfhi(v.z); o[8 * c + 6] += pr * bflo(v.w); o[8 * c + 7] += pr * bfhi(v.w); }
        }
        const float inv = 1.f / l;
        bf16* op = proj + (size_t)row * LDP0 + P0_Q + h * 64;
#pragma unroll
        for (int c = 0; c < 8; ++c) { u32x4 v; v.x = pk2(o[8 * c] * inv, o[8 * c + 1] * inv); v.y = pk2(o[8 * c + 2] * inv, o[8 * c + 3] * inv); v.z = pk2(o[8 * c + 4] * inv, o[8 * c + 5] * inv); v.w = pk2(o[8 * c + 6] * inv, o[8 * c + 7] * inv);
            *(u32x4*)(op + 8 * c) = v; }
    }
}

__device__ __forceinline__ void gate_phase(Frame& F) {
    bf16* proj = (bf16*)(F.ws + WS0_PROJ);
    const bf16* yb = (const bf16*)(F.ws + WS0_XN);
    const bf16* xbc = (const bf16*)((unsigned char*)F.out + DO_XBC);
    const int gw = F.vcu * NWAVES + F.wave, NGW = F.G * NWAVES;
    for (int m = gw; m < M; m += NGW) {
        f32x4 v[4]; float ss = 0.f;
#pragma unroll
        for (int j = 0; j < 4; ++j) { const int c = 4 * F.lane + 256 * j;
            const u32x2 zf = *(const u32x2*)(proj + (size_t)m * LDP0 + P0_Z + c), yf = *(const u32x2*)(proj + (size_t)m * LDP0 + P0_XBC + c), ybv = *(const u32x2*)(yb + (size_t)m * DM + c), xs = *(const u32x2*)(xbc + (size_t)m * CONVCH + c);
            const float dsk = F.d_skip[c >> 6];
            f32x4 y; y.x = bflo(yf.x) + bflo(ybv.x) + dsk * bflo(xs.x); y.y = bfhi(yf.x) + bfhi(ybv.x) + dsk * bfhi(xs.x); y.z = bflo(yf.y) + bflo(ybv.y) + dsk * bflo(xs.y); y.w = bfhi(yf.y) + bfhi(ybv.y) + dsk * bfhi(xs.y);
            y.x *= silu_f(bflo(zf.x)); y.y *= silu_f(bfhi(zf.x)); y.z *= silu_f(bflo(zf.y)); y.w *= silu_f(bfhi(zf.y));
            v[j] = y; ss += (y.x * y.x + y.y * y.y) + (y.z * y.z + y.w * y.w); }
        const float rstd = rsqrtf(wave_sum(ss) * (1.f / DM) + EPS);
#pragma unroll
        for (int j = 0; j < 4; ++j) { const int c = 4 * F.lane + 256 * j; const f32x4 g = *(const f32x4*)(F.ssd_norm + c); const f32x4 o = v[j] * rstd * g;
            u32x2 w; w.x = pk2(o.x, o.y); w.y = pk2(o.z, o.w); *(u32x2*)(proj + (size_t)m * LDP0 + P0_Z + c) = w; }
    }
}

__device__ __forceinline__ void mlstm_simple_item(Frame& F, int item, int dir) {
    const int b = item >> 3, h = item & 7;
    const int v = F.tid & 255, kh = F.tid >> 8;
    const bf16* proj = (const bf16*)(F.ws + WS1_PROJ);
    const float* gates = (const float*)(F.ws + WS1_GATES);
    bf16* H = (bf16*)(F.ws + WS1_H);
    LAS float* qs = (LAS float*)F.lds;
    LAS float* red = qs + 256;
    float C[64], nn[64];
#pragma unroll
    for (int j = 0; j < 64; ++j) { C[j] = 0.f; nn[j] = 0.f; }
    for (int tt = 0; tt < SEQ; ++tt) {
        const int tok = dir ? SEQ - 1 - tt : tt; const size_t row = (size_t)b * SEQ + tok;
        if (F.tid < 256) { const int which = F.tid >> 7, kk = F.tid & 127; qs[F.tid] = bf2f(proj[row * LDP1 + (which ? P1_K : P1_Q) + h * 128 + kk]); }
        const float ig = gates[row * 32 + (dir * 2 + 0) * 8 + h], fg = gates[row * 32 + (dir * 2 + 1) * 8 + h];
        const float fs = sigmoid_f(fg), ie = __expf(ig);
        const float vv = bf2f(proj[row * LDP1 + P1_V + h * 256 + v]);
        __syncthreads();
        float num = 0.f, den = 0.f;
#pragma unroll
        for (int j = 0; j < 64; ++j) { const float kq = qs[kh * 64 + j], kk = qs[128 + kh * 64 + j];
            C[j] = fs * C[j] + (ie * kk) * vv; nn[j] = fs * nn[j] + ie * kk; num += kq * C[j]; den += kq * nn[j]; }
        red[kh * 256 + v] = num; if (v == 0) red[512 + kh] = den;
        __syncthreads();
        if (kh == 0) {
            const float nt = red[v] + red[256 + v], dn = red[512] + red[513];
            float hv = nt / fmaxf(fabsf(dn), 1.f);
            bf16* hp = H + row * 2048 + h * 256 + v;
            if (dir) hv += bf2f(*hp);
            *hp = (bf16)f2bf(hv);
        }
    }
}
__device__ __forceinline__ void headstat_phase(Frame& F) {
    const bf16* H = (const bf16*)(F.ws + WS1_H); float* RS = (float*)(F.ws + WS1_RS);
    const int gw = F.vcu * NWAVES + F.wave, NGW = F.G * NWAVES;
    for (int m = gw; m < M; m += NGW) {
        float ss = 0.f;
#pragma unroll
        for (int c = 0; c < 4; ++c) { const u32x4 w = *(const u32x4*)(H + (size_t)m * 2048 + F.lane * 32 + 8 * c);
            const float a0 = bflo(w.x), a1 = bfhi(w.x), a2 = bflo(w.y), a3 = bfhi(w.y), a4 = bflo(w.z), a5 = bfhi(w.z), a6 = bflo(w.w), a7 = bfhi(w.w);
            ss += (a0 * a0 + a1 * a1) + (a2 * a2 + a3 * a3) + (a4 * a4 + a5 * a5) + (a6 * a6 + a7 * a7); }
        ss += __shfl_xor(ss, 1); ss += __shfl_xor(ss, 2); ss += __shfl_xor(ss, 4);
        if ((F.lane & 7) == 0) RS[(size_t)m * 8 + (F.lane >> 3)] = rsqrtf(ss * (1.f / 256.f) + EPS);
    }
}

__global__ void __launch_bounds__(NTHREADS, 2) mega_fwd(Args args) {
    extern __shared__ __attribute__((aligned(16))) unsigned char lds_raw[];
    Frame F;
    F.lds = (LAS unsigned char*)lds_raw;
    F.tid = threadIdx.x; F.lane = F.tid & 63; F.wave = __builtin_amdgcn_readfirstlane(F.tid >> 6);
    F.G = gridDim.x; { const int bx = blockIdx.x; F.vcu = (F.G % 8 == 0) ? (bx % 8) * (F.G / 8) + bx / 8 : bx; }
    F.x = args.in[0]; F.c = args.in[1]; F.ada_w = args.in[2]; F.ada_b = args.in[3]; F.norm_g = args.in[4]; F.mlp_w1 = args.in[5]; F.mlp_w2 = args.in[6];
    F.ab_w_in = args.in[7]; F.conv_w = args.in[8]; F.conv_b = args.in[9]; F.dt_bias = args.in[10]; F.a_log = args.in[11]; F.d_skip = args.in[12]; F.ssd_norm = args.in[13];
    F.rpb = args.in[14]; F.ab_w_out = args.in[15]; F.ml_w_in = args.in[16]; F.gate_b = args.in[17]; F.head_norm = args.in[18]; F.ml_w_out = args.in[19];
    F.out = args.out; F.ws = args.ws;
    unsigned char* ws = args.ws;
    float* mod = (float*)(ws + WS_MOD);
    volatile LAS unsigned* MISC = (volatile LAS unsigned*)(F.lds + LDS_BYTES - 64);
    if (F.tid < 16) MISC[F.tid] = 0u;
    __syncthreads();
    XcdBarrier bar; bar.bar = (unsigned*)(ws + WS_CTL) + 4096; bar.x = 0; bar.st = nullptr;
    if (MK_ONE_LAUNCH) bar = xcd_barrier_post((unsigned*)(ws + WS_CTL) + 4096, MISC + 8);
    const int lo = args.ph_lo, hi = args.ph_hi;
#define IN(k) (lo <= (k) && (k) < hi)
#define SEAM(k) do { if (IN(k) && IN((k) + 1)) xcd_barrier(bar); } while (0)

    if (IN(0)) {
        const TrJob jobs[7] = {
            {F.ab_w_in, 1024, ABIN, 0, 1024, (bf16*)(ws + W0_IN)},
            {F.ab_w_in, 1024, ABIN, 2592, 3072, (bf16*)(ws + W0_IN) + (size_t)1024 * 1024},
            {F.ab_w_in, 1024, ABIN, 1024, 1536, (bf16*)(ws + W0_IN) + (size_t)4096 * 1024},
            {F.ab_w_in, 1024, ABIN, 2560, 32, (bf16*)(ws + W0_DT)},
            {F.ab_w_out, 2048, 1024, 0, 1024, (bf16*)(ws + W0_OUT)},
            {F.mlp_w1, 1024, FF, 0, FF, (bf16*)(ws + W0_W1)},
            {F.mlp_w2, FF, 1024, 0, 1024, (bf16*)(ws + W0_W2)}};
        transpose_jobs(F, jobs);
        __syncthreads();
        mod_phase(F);
    }
    SEAM(0);
    if (IN(1)) rowpass<false, true>(F, F.x, nullptr, nullptr, nullptr, nullptr, F.norm_g + 0, mod + 0, mod + 1024, (bf16*)(ws + WS0_XN));
    SEAM(1);
    if (IN(2)) {
        EpiBf16 E{(bf16*)(ws + WS0_PROJ), LDP0, 0, 1.f};
        gemm_simple(F, (const bf16*)(ws + WS0_XN), DM, (const bf16*)(ws + W0_IN), M, 1024, DM, E);
        EpiBf16 Eq{(bf16*)(ws + WS0_PROJ) + P0_Q, LDP0, 1024, 0.125f};
        gemm_simple(F, (const bf16*)(ws + WS0_XN), DM, (const bf16*)(ws + W0_IN) + (size_t)1024 * 1024, M, 1024, DM, Eq);
        EpiBf16 Er{(bf16*)(ws + WS0_PROJ) + P0_K, LDP0, 0, 1.f};
        gemm_simple(F, (const bf16*)(ws + WS0_XN), DM, (const bf16*)(ws + W0_IN) + (size_t)2048 * 1024, M, LDP0 - 2048, DM, Er);
        EpiDt Ed{(float*)(ws + WS0_DT), F.dt_bias};
        gemm_simple(F, (const bf16*)(ws + WS0_XN), DM, (const bf16*)(ws + W0_DT), M, 32, DM, Ed);
    }
    SEAM(2);
    if (IN(3)) conv_phase(F);
    SEAM(3);
    if (IN(4)) {
        if ((int)blockIdx.x < 128) ssd_simple_item(F, blockIdx.x);
        else na_simple(F, blockIdx.x - 128, F.G - 128);
    }
    SEAM(4);
    if (IN(5)) gate_phase(F);
    SEAM(5);
    if (IN(6)) { EpiBf16 E{(bf16*)(ws + WS0_XN), DM, 0, 1.f};
        gemm_simple(F, (const bf16*)(ws + WS0_PROJ), LDP0, (const bf16*)(ws + W0_OUT), M, DM, 2048, E); }
    SEAM(6);
    if (IN(7)) rowpass<true, true>(F, F.x, (const bf16*)(ws + WS0_XN), mod + 2048, F.norm_g + 1024, F.out, F.norm_g + 2048, mod + 3072, mod + 4096, (bf16*)(ws + WS0_XN));
    SEAM(7);
    if (IN(8)) { EpiRelu2 E{(bf16*)(ws + WS0_U), FF}; gemm_simple(F, (const bf16*)(ws + WS0_XN), DM, (const bf16*)(ws + W0_W1), M, FF, DM, E); }
    SEAM(8);
    if (IN(9)) { EpiBf16 E{(bf16*)(ws + WS0_MLPOUT), DM, 0, 1.f}; gemm_simple(F, (const bf16*)(ws + WS0_U), FF, (const bf16*)(ws + W0_W2), M, DM, FF, E); }
    SEAM(9);
    if (IN(10)) {
        rowpass<true, true>(F, F.out, (const bf16*)(ws + WS0_MLPOUT), mod + 5120, F.norm_g + 3072, F.out, F.norm_g + 4096, mod + 4 * 6144, mod + 4 * 6144 + 1024, (bf16*)(ws + WS1_XN));
        const TrJob jobs[4] = {
            {F.ml_w_in, 1024, MLIN, 0, 4096, (bf16*)(ws + W1_QKV)},
            {F.ml_w_in, 1024, MLIN, 4096, 2048, (bf16*)(ws + W1_O)},
            {F.ml_w_in, 1024, MLIN, 6144, 32, (bf16*)(ws + W1_G)},
            {F.ml_w_out, 2048, 1024, 0, 1024, (bf16*)(ws + W1_OUT)}};
        transpose_jobs(F, jobs);
    }
    SEAM(10);
    if (IN(11)) {
        EpiBf16 E{(bf16*)(ws + WS1_PROJ), LDP1, 1024, 0.08838834764831845f};
        gemm_simple(F, (const bf16*)(ws + WS1_XN), DM, (const bf16*)(ws + W1_QKV), M, 4096, DM, E);
        EpiGates Eg{(float*)(ws + WS1_GATES), F.gate_b};
        gemm_simple(F, (const bf16*)(ws + WS1_XN), DM, (const bf16*)(ws + W1_G), M, 32, DM, Eg);
    }
    SEAM(11);
    if (IN(12)) { if ((int)blockIdx.x < 32) mlstm_simple_item(F, blockIdx.x, 0); }
    SEAM(12);
    if (IN(13)) { if ((int)blockIdx.x < 32) mlstm_simple_item(F, blockIdx.x, 1); }
    SEAM(13);
    if (IN(14)) headstat_phase(F);
    SEAM(14);
    if (IN(15)) { EpiOGate E{(bf16*)(ws + WS1_H), (const float*)(ws + WS1_RS), F.head_norm};
        gemm_simple(F, (const bf16*)(ws + WS1_XN), DM, (const bf16*)(ws + W1_O), M, 2048, DM, E); }
    SEAM(15);
    if (IN(16)) { EpiBf16 E{(bf16*)(ws + WS1_MIX), DM, 0, 1.f}; gemm_simple(F, (const bf16*)(ws + WS1_H), 2048, (const bf16*)(ws + W1_OUT), M, DM, 2048, E); }
    SEAM(16);
    if (IN(17)) {
        rowpass<true, true>(F, F.out, (const bf16*)(ws + WS1_MIX), mod + 4 * 6144 + 2048, F.norm_g + 4096 + 1024, F.out, F.norm_g + 4096 + 2048, mod + 4 * 6144 + 3072, mod + 4 * 6144 + 4096, (bf16*)(ws + WS1_XN));
        const TrJob jobs[2] = {
            {F.mlp_w1 + (size_t)1024 * FF, 1024, FF, 0, FF, (bf16*)(ws + W1_W1)},
            {F.mlp_w2 + (size_t)FF * 1024, FF, 1024, 0, 1024, (bf16*)(ws + W1_W2)}};
        transpose_jobs(F, jobs);
    }
    SEAM(17);
    if (IN(18)) { EpiRelu2 E{(bf16*)(ws + WS1_U), FF}; gemm_simple(F, (const bf16*)(ws + WS1_XN), DM, (const bf16*)(ws + W1_W1), M, FF, DM, E); }
    SEAM(18);
    if (IN(19)) { EpiBf16 E{(bf16*)(ws + WS1_MLPOUT), DM, 0, 1.f}; gemm_simple(F, (const bf16*)(ws + WS1_U), FF, (const bf16*)(ws + W1_W2), M, DM, FF, E); }
    SEAM(19);
    if (IN(20)) rowpass<true, false>(F, F.out, (const bf16*)(ws + WS1_MLPOUT), mod + 4 * 6144 + 5120, F.norm_g + 4096 + 3072, F.out, nullptr, nullptr, nullptr, nullptr);
#undef IN
#undef SEAM
}

extern "C" void kernel_launch(void* const* d_in, const int* in_sizes, int n_in, void* d_out, int out_size, void* d_ws, size_t ws_size, hipStream_t stream) {
    static int grid = 0;
    if (grid == 0) {
        if (n_in != 20 || out_size != M * DM || ws_size < WS_END) { fprintf(stderr, "kernel_launch: unexpected problem shape (n_in %d out %d ws %zu)\n", n_in, out_size, ws_size); grid = -1; return; }
        int dev = 0, cus = 0;
        if (hipGetDevice(&dev) != hipSuccess || hipDeviceGetAttribute(&cus, hipDeviceAttributeMultiprocessorCount, dev) != hipSuccess) { grid = -1; return; }
        if (hipFuncSetAttribute((const void*)mega_fwd, hipFuncAttributeMaxDynamicSharedMemorySize, LDS_BYTES) != hipSuccess) { fprintf(stderr, "kernel_launch: hipFuncSetAttribute failed\n"); grid = -1; return; }
        int per_cu = 0;
        if (hipOccupancyMaxActiveBlocksPerMultiprocessor(&per_cu, (const void*)mega_fwd, NTHREADS, LDS_BYTES) != hipSuccess || per_cu < 1) fprintf(stderr, "kernel_launch: occupancy query says %d\n", per_cu);
        (void)hipGetLastError();
        grid = cus;
    }
    if (grid < 0) return;
    (void)hipMemsetAsync((char*)d_ws + WS_CTL, 0, CTL_ZERO_BYTES, stream);
    Args a{};
    for (int i = 0; i < 20; ++i) a.in[i] = (const float*)d_in[i];
    a.out = (float*)d_out; a.ws = (unsigned char*)d_ws;
#if MK_ONE_LAUNCH
    a.ph_lo = 0; a.ph_hi = NPHASE;
    hipLaunchKernelGGL(mega_fwd, dim3(grid), dim3(NTHREADS), LDS_BYTES, stream, a);
#else
    for (int p = 0; p < NPHASE; ++p) { a.ph_lo = p; a.ph_hi = p + 1; hipLaunchKernelGGL(mega_fwd, dim3(grid), dim3(NTHREADS), LDS_BYTES, stream, a); }
#endif
}
```

```cpp
#include <hip/hip_runtime.h>
#include <cstdio>
#include <cstdint>

#define GAS __attribute__((address_space(1)))
#define LAS __attribute__((address_space(3)))
typedef unsigned short bf16;
typedef short bf16x8 __attribute__((ext_vector_type(8)));
typedef float f32x4 __attribute__((ext_vector_type(4)));
typedef unsigned u32x4 __attribute__((ext_vector_type(4)));
typedef unsigned u32x2 __attribute__((ext_vector_type(2)));

#ifndef MK_ONE_LAUNCH
#define MK_ONE_LAUNCH 1
#endif

constexpr int NWAVES = 8, NTHREADS = 512;
constexpr int BATCH = 4, SEQ = 4096, DM = 1024, M = BATCH * SEQ, FF = 4096;
constexpr float EPS = 1e-6f;
constexpr int SH = 16, SP = 64, SN = 128, CONVCH = 1536, ABIN = 5664;
constexpr int LDP0 = 5632, P0_Z = 0, P0_Q = 1024, P0_K = 2048, P0_V = 3072, P0_XBC = 4096;
constexpr int MH = 8, MDK = 128, MDV = 256, MLIN = 6176, LDP1 = 4096, P1_Q = 0, P1_K = 1024, P1_V = 2048;
constexpr int NPHASE = 21;

constexpr size_t MiB = 1u << 20;
constexpr size_t WS_CTL = 0, CTL_ZERO_BYTES = 1 * MiB;
constexpr size_t WS_MOD = 1 * MiB;
constexpr size_t W0_IN = 2 * MiB, W0_DT = 13 * MiB, W0_OUT = 14 * MiB, W0_W1 = 18 * MiB, W0_W2 = 26 * MiB;
constexpr size_t WS0_XN = 36 * MiB, WS0_DT = 68 * MiB, WS0_PROJ = 70 * MiB, WS0_U = 70 * MiB, WS0_MLPOUT = 198 * MiB;
constexpr size_t W1_QKV = 2 * MiB, W1_O = 10 * MiB, W1_G = 14 * MiB, W1_OUT = 15 * MiB, W1_W1 = 2 * MiB, W1_W2 = 10 * MiB;
constexpr size_t WS1_GATES = 19 * MiB, WS1_XN = 21 * MiB, WS1_PROJ = 53 * MiB, WS1_H = 181 * MiB, WS1_RS = 245 * MiB;
constexpr size_t WS1_MIX = 53 * MiB, WS1_U = 53 * MiB, WS1_MLPOUT = 181 * MiB;
constexpr size_t WS_END = 256 * MiB;
constexpr size_t DO_XBC = 0;

constexpr int LDS_BYTES = 147456;

__device__ __forceinline__ float bf2f(unsigned v) { return __uint_as_float(v << 16); }
__device__ __forceinline__ unsigned f2bf(float f) { unsigned u = __float_as_uint(f); return (u + 0x7fffu + ((u >> 16) & 1u)) >> 16; }
__device__ __forceinline__ unsigned pk2(float lo, float hi) { return f2bf(lo) | (f2bf(hi) << 16); }
__device__ __forceinline__ float bflo(unsigned w) { return __uint_as_float(w << 16); }
__device__ __forceinline__ float bfhi(unsigned w) { return __uint_as_float(w & 0xffff0000u); }
__device__ __forceinline__ float wave_sum(float v) {
#pragma unroll
    for (int o = 1; o < 64; o <<= 1) v += __shfl_xor(v, o);
    return v;
}
__device__ __forceinline__ float silu_f(float x) { return x / (1.f + __expf(-x)); }
__device__ __forceinline__ float sigmoid_f(float x) { return 1.f / (1.f + __expf(-x)); }
__device__ __forceinline__ float softplus_f(float x) { return x > 20.f ? x : log1pf(__expf(x)); }

#define XB_TMO      128
#define XB_XCNT(j)  (256  + 64 * (j))
#define XB_XSUB(j)  (1280 + 64 * (j))
#define XB_XGEN(j)  (2304 + 64 * (j))
#define XB_TOP      3328
#define XB_TOPGEN   3392
#define XCD_BAR_WORDS 3456
#define XB_SPIN_CAP (1u << 22)
__device__ __forceinline__ unsigned xb_ld(unsigned* p)              { return __hip_atomic_load(p, __ATOMIC_RELAXED, __HIP_MEMORY_SCOPE_AGENT); }
__device__ __forceinline__ unsigned xb_add(unsigned* p, unsigned v) { return __hip_atomic_fetch_add(p, v, __ATOMIC_RELAXED, __HIP_MEMORY_SCOPE_AGENT); }
__device__ __forceinline__ unsigned xb_xcc_id() { return (unsigned)__builtin_amdgcn_s_getreg((3 << 11) | 20) & 0xFu; }
#define XB_SPIN(cond, bar) do { unsigned _sp = 0; while (cond) { __builtin_amdgcn_s_sleep(1); \
    if ((++_sp & 255u) == 0u) { if (xb_ld(&(bar)[XB_TMO])) break; if (_sp > XB_SPIN_CAP) { atomicAdd(&(bar)[XB_TMO], 1u); break; } } } } while (0)
struct XcdBarrier { unsigned* bar; unsigned x; volatile LAS unsigned* st; };
__device__ __forceinline__ XcdBarrier xcd_barrier_post(unsigned* bar, volatile LAS unsigned* st) {
    XcdBarrier b; b.bar = bar; b.x = xb_xcc_id(); b.st = st;
    if (threadIdx.x == 0) (void)xb_add(&bar[XB_XCNT(b.x)], 1u);
    return b;
}
__device__ __forceinline__ void xcd_barrier_complete(unsigned* bar, unsigned x, unsigned& nloc, unsigned& nx) {
    const unsigned G = gridDim.x * gridDim.y * gridDim.z;
    unsigned sum, cnt, mine, sp = 0u;
    for (;;) {
        sum = 0u; cnt = 0u; mine = 0u;
#pragma unroll
        for (unsigned j = 0; j < 16; ++j) { const unsigned c = xb_ld(&bar[XB_XCNT(j)]); sum += c; cnt += (c > 0u) ? 1u : 0u; mine = (j == x) ? c : mine; }
        if (sum == G) break;
        __builtin_amdgcn_s_sleep(1);
        if ((++sp & 255u) == 0u) { if (xb_ld(&bar[XB_TMO])) break; if (sp > XB_SPIN_CAP) { atomicAdd(&bar[XB_TMO], 1u); break; } }
    }
    nloc = mine > 0u ? mine : 1u; nx = cnt > 0u ? cnt : 1u;
}
__device__ __forceinline__ void xcd_barrier(const XcdBarrier& b) {
    asm volatile("s_waitcnt vmcnt(0)" ::: "memory");
    __syncthreads();
    if (threadIdx.x == 0) {
        unsigned* bar = b.bar;
        __builtin_amdgcn_s_waitcnt(0);
        unsigned nloc = b.st[0], nx = b.st[1];
        if (nloc == 0u) { xcd_barrier_complete(bar, b.x, nloc, nx); b.st[0] = nloc; b.st[1] = nx; }
        const unsigned old = xb_add(&bar[XB_XSUB(b.x)], 1u);
        const unsigned gen = old / nloc;
        if (old + 1u == (gen + 1u) * nloc) {
            __builtin_amdgcn_fence(__ATOMIC_RELEASE, "agent");
            asm volatile("s_waitcnt vmcnt(0)" ::: "memory");
            const unsigned og = xb_add(&bar[XB_TOP], 1u);
            const unsigned tg = og / nx;
            if (og + 1u == (tg + 1u) * nx) xb_add(&bar[XB_TOPGEN], 1u);
            else XB_SPIN(xb_ld(&bar[XB_TOPGEN]) == tg, bar);
            __builtin_amdgcn_fence(__ATOMIC_ACQUIRE, "agent");
            xb_add(&bar[XB_XGEN(b.x)], 1u);
            asm volatile("s_waitcnt vmcnt(0)" ::: "memory");
        } else {
            XB_SPIN(xb_ld(&bar[XB_XGEN(b.x)]) == gen, bar);
            __builtin_amdgcn_fence(__ATOMIC_ACQUIRE, "agent");
            asm volatile("s_waitcnt vmcnt(0)" ::: "memory");
        }
    }
    __syncthreads();
}

struct Args { const float* in[20]; float* out; unsigned char* ws; int ph_lo, ph_hi; };
struct Frame {
    LAS unsigned char* lds;
    int tid, lane, wave, G, vcu;
    const float *x, *c, *ada_w, *ada_b, *norm_g, *mlp_w1, *mlp_w2, *ab_w_in, *conv_w, *conv_b, *dt_bias, *a_log, *d_skip, *ssd_norm, *rpb, *ab_w_out,
                *ml_w_in, *gate_b, *head_norm, *ml_w_out;
    float* out; unsigned char* ws;
};

__device__ __forceinline__ void transpose_item(const float* W, int K, int ldw, int c0, int ncols, bf16* WT, LAS float* scr, int item, int lane) {
    const int nblk = ncols / 32, kb = item / nblk, nb = item % nblk, k0 = 64 * kb, n0 = 32 * nb;
#pragma unroll 8
    for (int i = 0; i < 32; ++i) { const int kk = 2 * i + (lane >> 5); scr[kk * 33 + (lane & 31)] = W[(size_t)(k0 + kk) * ldw + c0 + n0 + (lane & 31)]; }
    asm volatile("s_waitcnt lgkmcnt(0)" ::: "memory");
    const int c = lane & 7;
#pragma unroll
    for (int j = 0; j < 4; ++j) { const int n = (lane >> 3) + 8 * j; const LAS float* s = scr + (8 * c) * 33 + n;
        u32x4 o; o.x = pk2(s[0 * 33], s[1 * 33]); o.y = pk2(s[2 * 33], s[3 * 33]); o.z = pk2(s[4 * 33], s[5 * 33]); o.w = pk2(s[6 * 33], s[7 * 33]);
        *(u32x4*)(WT + (size_t)(n0 + n) * K + k0 + 8 * c) = o; }
    asm volatile("s_waitcnt lgkmcnt(0)" ::: "memory");
}
struct TrJob { const float* W; int K, ldw, c0, ncols; bf16* WT; };
template <int NJ> __device__ __forceinline__ void transpose_jobs(Frame& F, const TrJob (&jobs)[NJ]) {
    LAS float* scr = (LAS float*)(F.lds + F.wave * 16384);
    const int gw = F.vcu * NWAVES + F.wave, NGW = F.G * NWAVES;
    int base = 0;
#pragma unroll
    for (int j = 0; j < NJ; ++j) {
        const int nitems = (jobs[j].K / 64) * (jobs[j].ncols / 32);
        int first = gw - (base % NGW); if (first < 0) first += NGW;
        for (int it = first; it < nitems; it += NGW) transpose_item(jobs[j].W, jobs[j].K, jobs[j].ldw, jobs[j].c0, jobs[j].ncols, jobs[j].WT, scr, it, F.lane);
        base += nitems;
    }
}

__device__ __forceinline__ void mod_phase(Frame& F) {
    float* mod = (float*)(F.ws + WS_MOD);
    LAS float* red = (LAS float*)F.lds;
    for (int item = blockIdx.x; item < 2 * 96; item += F.G) {
        const int l = item / 96, cg = item % 96, col = cg * 64 + F.lane, kg = F.wave;
        float acc0 = 0.f, acc1 = 0.f, acc2 = 0.f, acc3 = 0.f;
        const float* w = F.ada_w + ((size_t)l * 1024 + kg * 128) * 6144 + col;
        const float* cc = F.c + kg * 128;
#pragma unroll 4
        for (int k = 0; k < 128; ++k) {
            const float wv = w[(size_t)k * 6144];
            acc0 += silu_f(cc[k]) * wv; acc1 += silu_f(cc[1024 + k]) * wv; acc2 += silu_f(cc[2048 + k]) * wv; acc3 += silu_f(cc[3072 + k]) * wv;
        }
        red[(kg * 4 + 0) * 64 + F.lane] = acc0; red[(kg * 4 + 1) * 64 + F.lane] = acc1; red[(kg * 4 + 2) * 64 + F.lane] = acc2; red[(kg * 4 + 3) * 64 + F.lane] = acc3;
        __syncthreads();
        if (F.tid < 256) { const int b = F.tid >> 6, ln = F.tid & 63; float s = 0.f;
#pragma unroll
            for (int g = 0; g < 8; ++g) s += red[(g * 4 + b) * 64 + ln];
            mod[((size_t)l * 4 + b) * 6144 + cg * 64 + ln] = s + F.ada_b[l * 6144 + cg * 64 + ln]; }
        __syncthreads();
    }
}

template <bool HAS_MIX, bool HAS_XN>
__device__ __forceinline__ void rowpass(Frame& F, const float* xin, const bf16* mix, const float* gate, const float* ng_mix, float* xout,
                                        const float* ng_x, const float* sh, const float* sc, bf16* xn) {
    const int gw = F.vcu * NWAVES + F.wave, NGW = F.G * NWAVES;
    for (int m = gw; m < M; m += NGW) {
        const int b = m / SEQ;
        f32x4 v[4];
#pragma unroll
        for (int j = 0; j < 4; ++j) v[j] = *(const f32x4*)(xin + (size_t)m * DM + 4 * F.lane + 256 * j);
        if (HAS_MIX) {
            f32x4 mv[4]; float ss = 0.f;
#pragma unroll
            for (int j = 0; j < 4; ++j) { const u32x2 w = *(const u32x2*)(mix + (size_t)m * DM + 4 * F.lane + 256 * j);
                mv[j] = (f32x4){bflo(w.x), bfhi(w.x), bflo(w.y), bfhi(w.y)}; ss += (mv[j].x * mv[j].x + mv[j].y * mv[j].y) + (mv[j].z * mv[j].z + mv[j].w * mv[j].w); }
            const float rstd = rsqrtf(wave_sum(ss) * (1.f / DM) + EPS);
#pragma unroll
            for (int j = 0; j < 4; ++j) { const int c = 4 * F.lane + 256 * j; const f32x4 g = *(const f32x4*)(gate + (size_t)b * 6144 + c), ng = *(const f32x4*)(ng_mix + c);
                v[j] = v[j] + g * (mv[j] * rstd * ng); *(f32x4*)(xout + (size_t)m * DM + c) = v[j]; }
        }
        if (HAS_XN) {
            float ss = 0.f;
#pragma unroll
            for (int j = 0; j < 4; ++j) ss += (v[j].x * v[j].x + v[j].y * v[j].y) + (v[j].z * v[j].z + v[j].w * v[j].w);
            const float rstd = rsqrtf(wave_sum(ss) * (1.f / DM) + EPS);
#pragma unroll
            for (int j = 0; j < 4; ++j) { const int c = 4 * F.lane + 256 * j; const f32x4 ng = *(const f32x4*)(ng_x + c), s1 = *(const f32x4*)(sc + (size_t)b * 6144 + c), s0 = *(const f32x4*)(sh + (size_t)b * 6144 + c);
                const f32x4 o = (v[j] * rstd * ng) * (s1 + 1.f) + s0; u32x2 w; w.x = pk2(o.x, o.y); w.y = pk2(o.z, o.w);
                *(u32x2*)(xn + (size_t)m * DM + c) = w; }
        }
    }
}

template <class Epi>
__device__ __forceinline__ void gemm_simple(Frame& F, const bf16* A, int lda, const bf16* Bt, int Mr, int N, int K, const Epi& E) {
    const int gw = F.vcu * NWAVES + F.wave, NGW = F.G * NWAVES;
    const int tn_n = N / 32, ntiles = (Mr / 32) * tn_n;
    const int fr = F.lane & 15, fq = F.lane >> 4;
    for (int t = gw; t < ntiles; t += NGW) {
        const int tm = t / tn_n, tn = t % tn_n, m0 = tm * 32, n0 = tn * 32;
        f32x4 acc[2][2];
#pragma unroll
        for (int i = 0; i < 2; ++i)
#pragma unroll
            for (int j = 0; j < 2; ++j) acc[i][j] = (f32x4){0.f, 0.f, 0.f, 0.f};
        const bf16* ap = A + (size_t)(m0 + fr) * lda + fq * 8;
        const bf16* bp = Bt + (size_t)(n0 + fr) * K + fq * 8;
#pragma unroll 2
        for (int k0 = 0; k0 < K; k0 += 32) {
            const bf16x8 a0 = *(const bf16x8*)(ap + k0), a1 = *(const bf16x8*)(ap + (size_t)16 * lda + k0);
            const bf16x8 b0 = *(const bf16x8*)(bp + k0), b1 = *(const bf16x8*)(bp + (size_t)16 * K + k0);
            acc[0][0] = __builtin_amdgcn_mfma_f32_16x16x32_bf16(b0, a0, acc[0][0], 0, 0, 0);
            acc[0][1] = __builtin_amdgcn_mfma_f32_16x16x32_bf16(b1, a0, acc[0][1], 0, 0, 0);
            acc[1][0] = __builtin_amdgcn_mfma_f32_16x16x32_bf16(b0, a1, acc[1][0], 0, 0, 0);
            acc[1][1] = __builtin_amdgcn_mfma_f32_16x16x32_bf16(b1, a1, acc[1][1], 0, 0, 0);
        }
#pragma unroll
        for (int i = 0; i < 2; ++i)
#pragma unroll
            for (int j = 0; j < 2; ++j) E.put4(m0 + 16 * i + fr, n0 + 16 * j + 4 * fq, acc[i][j]);
    }
}
struct EpiBf16 {
    bf16* O; int ldc; int scale_cols; float scale;
    __device__ __forceinline__ void put4(int row, int col, f32x4 v) const {
        if (col < scale_cols) v = v * scale;
        u32x2 w; w.x = pk2(v.x, v.y); w.y = pk2(v.z, v.w); *(u32x2*)(O + (size_t)row * ldc + col) = w; }
};
struct EpiRelu2 {
    bf16* O; int ldc;
    __device__ __forceinline__ void put4(int row, int col, f32x4 v) const {
        v.x = fmaxf(v.x, 0.f); v.y = fmaxf(v.y, 0.f); v.z = fmaxf(v.z, 0.f); v.w = fmaxf(v.w, 0.f); v = v * v;
        u32x2 w; w.x = pk2(v.x, v.y); w.y = pk2(v.z, v.w); *(u32x2*)(O + (size_t)row * ldc + col) = w; }
};
struct EpiDt {
    float* O; const float* bias;
    __device__ __forceinline__ void put4(int row, int col, f32x4 v) const {
        const f32x4 b = *(const f32x4*)(bias + col); f32x4 o;
        o.x = softplus_f(v.x + b.x); o.y = softplus_f(v.y + b.y); o.z = softplus_f(v.z + b.z); o.w = softplus_f(v.w + b.w);
        *(f32x4*)(O + (size_t)row * 32 + col) = o; }
};
struct EpiGates {
    float* O; const float* bias;
    __device__ __forceinline__ void put4(int row, int col, f32x4 v) const { *(f32x4*)(O + (size_t)row * 32 + col) = v + *(const f32x4*)(bias + col); }
};
struct EpiOGate {
    bf16* H; const float* RS; const float* hg;
    __device__ __forceinline__ void put4(int row, int col, f32x4 v) const {
        bf16* p = H + (size_t)row * 2048 + col; const u32x2 w = *(const u32x2*)p; const float rs = RS[(size_t)row * 8 + (col >> 8)]; const f32x4 g = *(const f32x4*)(hg + col);
        f32x4 o; o.x = sigmoid_f(v.x) * bflo(w.x) * rs * g.x; o.y = sigmoid_f(v.y) * bfhi(w.x) * rs * g.y; o.z = sigmoid_f(v.z) * bflo(w.y) * rs * g.z; o.w = sigmoid_f(v.w) * bfhi(w.y) * rs * g.w;
        u32x2 r; r.x = pk2(o.x, o.y); r.y = pk2(o.z, o.w); *(u32x2*)p = r; }
};

__device__ __forceinline__ void conv_phase(Frame& F) {
    const bf16* proj = (const bf16*)(F.ws + WS0_PROJ);
    bf16* xbcp = (bf16*)((unsigned char*)F.out + DO_XBC);
    const size_t total = (size_t)M * (CONVCH / 8), stride = (size_t)F.G * NTHREADS;
    for (size_t i = (size_t)blockIdx.x * NTHREADS + F.tid; i < total; i += stride) {
        const int row = (int)(i / (CONVCH / 8)), cg = (int)(i % (CONVCH / 8)), c0 = cg * 8, t = row % SEQ;
        float acc[8];
#pragma unroll
        for (int e = 0; e < 8; ++e) acc[e] = F.conv_b[c0 + e];
#pragma unroll
        for (int j = 0; j < 5; ++j) {
            const int tt = t + j - 2;
            if (tt >= 0 && tt < SEQ) {
                const u32x4 w = *(const u32x4*)(proj + (size_t)(row + j - 2) * LDP0 + P0_XBC + c0);
                const f32x4 k0 = *(const f32x4*)(F.conv_w + j * CONVCH + c0), k1 = *(const f32x4*)(F.conv_w + j * CONVCH + c0 + 4);
                acc[0] += bflo(w.x) * k0.x; acc[1] += bfhi(w.x) * k0.y; acc[2] += bflo(w.y) * k0.z; acc[3] += bfhi(w.y) * k0.w;
                acc[4] += bflo(w.z) * k1.x; acc[5] += bfhi(w.z) * k1.y; acc[6] += bflo(w.w) * k1.z; acc[7] += bfhi(w.w) * k1.w;
            }
        }
        u32x4 o; o.x = pk2(silu_f(acc[0]), silu_f(acc[1])); o.y = pk2(silu_f(acc[2]), silu_f(acc[3])); o.z = pk2(silu_f(acc[4]), silu_f(acc[5])); o.w = pk2(silu_f(acc[6]), silu_f(acc[7]));
        *(u32x4*)(xbcp + (size_t)row * CONVCH + c0) = o;
    }
}

__device__ __forceinline__ void ssd_simple_item(Frame& F, int item) {
    const int dir = item >> 6, b = (item >> 4) & 3, h = item & 15, g = h >> 3;
    const int p = F.tid >> 3, nq = F.tid & 7;
    const float a = -__expf(F.a_log[dir * 16 + h]);
    const bf16* xbc = (const bf16*)((unsigned char*)F.out + DO_XBC);
    const float* dtv = (const float*)(F.ws + WS0_DT);
    bf16* Y; int ldy;
    if (dir == 0) { Y = (bf16*)(F.ws + WS0_PROJ) + P0_XBC; ldy = LDP0; } else { Y = (bf16*)(F.ws + WS0_XN); ldy = DM; }
    float S[16];
#pragma unroll
    for (int j = 0; j < 16; ++j) S[j] = 0.f;
    for (int tt = 0; tt < SEQ; ++tt) {
        const int tok = dir ? SEQ - 1 - tt : tt; const size_t row = (size_t)b * SEQ + tok;
        const float dt = dtv[row * 32 + dir * 16 + h];
        const float dA = __expf(dt * a);
        const float xv = bf2f(xbc[row * CONVCH + h * 64 + p]) * dt;
        const u32x4* Bp = (const u32x4*)(xbc + row * CONVCH + 1024 + g * 128 + nq * 16); const u32x4 b0 = Bp[0], b1 = Bp[1];
        const u32x4* Cp = (const u32x4*)(xbc + row * CONVCH + 1280 + g * 128 + nq * 16); const u32x4 c0 = Cp[0], c1 = Cp[1];
        const float Bv[16] = {bflo(b0.x), bfhi(b0.x), bflo(b0.y), bfhi(b0.y), bflo(b0.z), bfhi(b0.z), bflo(b0.w), bfhi(b0.w), bflo(b1.x), bfhi(b1.x), bflo(b1.y), bfhi(b1.y), bflo(b1.z), bfhi(b1.z), bflo(b1.w), bfhi(b1.w)};
        const float Cv[16] = {bflo(c0.x), bfhi(c0.x), bflo(c0.y), bfhi(c0.y), bflo(c0.z), bfhi(c0.z), bflo(c0.w), bfhi(c0.w), bflo(c1.x), bfhi(c1.x), bflo(c1.y), bfhi(c1.y), bflo(c1.z), bfhi(c1.z), bflo(c1.w), bfhi(c1.w)};
        float acc = 0.f;
#pragma unroll
        for (int j = 0; j < 16; ++j) { S[j] = dA * S[j] + xv * Bv[j]; acc += Cv[j] * S[j]; }
        acc += __shfl_xor(acc, 1); acc += __shfl_xor(acc, 2); acc += __shfl_xor(acc, 4);
        if (nq == 0) Y[row * ldy + h * 64 + p] = (bf16)f2bf(acc);
    }
}

__device__ __forceinline__ float dot64(const bf16* kp, const float (&q)[64]) {
    float s = 0.f;
#pragma unroll
    for (int c = 0; c < 8; ++c) { const u32x4 w = *(const u32x4*)(kp + 8 * c);
        s += q[8 * c] * bflo(w.x) + q[8 * c + 1] * bfhi(w.x) + q[8 * c + 2] * bflo(w.y) + q[8 * c + 3] * bfhi(w.y) + q[8 * c + 4] * bflo(w.z) + q[8 * c + 5] * bfhi(w.z) + q[8 * c + 6] * bflo(w.w) + q[8 * c + 7] * bfhi(w.w); }
    return s;
}
__device__ __forceinline__ void na_simple(Frame& F, int blk, int nblk) {
    bf16* proj = (bf16*)(F.ws + WS0_PROJ);
    const size_t total = (size_t)M * 16, stride = (size_t)nblk * NTHREADS;
    for (size_t i = (size_t)blk * NTHREADS + F.tid; i < total; i += stride) {
        const int row = (int)(i >> 4), h = (int)(i & 15), b = row / SEQ, t = row % SEQ, r = t >> 6, w = t & 63;
        int rs = r - 4; rs = rs < 0 ? 0 : (rs > 56 ? 56 : rs);
        int cs = w - 8; cs = cs < 0 ? 0 : (cs > 48 ? 48 : cs);
        float q[64];
        {
            const bf16* qp = proj + (size_t)row * LDP0 + P0_Q + h * 64;
#pragma unroll
            for (int c = 0; c < 8; ++c) { const u32x4 v = *(const u32x4*)(qp + 8 * c);
                q[8 * c] = bflo(v.x); q[8 * c + 1] = bfhi(v.x); q[8 * c + 2] = bflo(v.y); q[8 * c + 3] = bfhi(v.y); q[8 * c + 4] = bflo(v.z); q[8 * c + 5] = bfhi(v.z); q[8 * c + 6] = bflo(v.w); q[8 * c + 7] = bfhi(v.w); }
        }
        const float* rp = F.rpb + (size_t)h * 15 * 31;
        float mx = -1e30f;
        for (int ii = 0; ii < 8; ++ii) for (int jj = 0; jj < 16; ++jj) {
            const int kr = rs + ii, kc = cs + jj; const size_t krow = (size_t)b * SEQ + kr * 64 + kc;
            const float s = dot64(proj + krow * LDP0 + P0_K + h * 64, q) + rp[(kr - r + 7) * 31 + (kc - w + 15)];
            mx = fmaxf(mx, s);
        }
        float o[64]; float l = 0.f;
#pragma unroll
        for (int d = 0; d < 64; ++d) o[d] = 0.f;
        for (int ii = 0; ii < 8; ++ii) for (int jj = 0; jj < 16; ++jj) {
            const int kr = rs + ii, kc = cs + jj; const size_t krow = (size_t)b * SEQ + kr * 64 + kc;
            const float s = dot64(proj + krow * LDP0 + P0_K + h * 64, q) + rp[(kr - r + 7) * 31 + (kc - w + 15)];
            const float pr = __expf(s - mx); l += pr;
            const bf16* vp = proj + krow * LDP0 + P0_V + h * 64;
#pragma unroll
            for (int c = 0; c < 8; ++c) { const u32x4 v = *(const u32x4*)(vp + 8 * c);
                o[8 * c] += pr * bflo(v.x); o[8 * c + 1] += pr * bfhi(v.x); o[8 * c + 2] += pr * bflo(v.y); o[8 * c + 3] += pr * bfhi(v.y);
                o[8 * c + 4] += pr * bflo(v.z); o[8 * c + 5] += pr * bfhi(v.z); o[8 * c + 6] += pr * bflo(v.w); o[8 * c + 7] += pr * bfhi(v.w); }
        }
        const float inv = 1.f / l;
        bf16* op = proj + (size_t)row * LDP0 + P0_Q + h * 64;
#pragma unroll
        for (int c = 0; c < 8; ++c) { u32x4 v; v.x = pk2(o[8 * c] * inv, o[8 * c + 1] * inv); v.y = pk2(o[8 * c + 2] * inv, o[8 * c + 3] * inv); v.z = pk2(o[8 * c + 4] * inv, o[8 * c + 5] * inv); v.w = pk2(o[8 * c + 6] * inv, o[8 * c + 7] * inv);
            *(u32x4*)(op + 8 * c) = v; }
    }
}

__device__ __forceinline__ void gate_phase(Frame& F) {
    bf16* proj = (bf16*)(F.ws + WS0_PROJ);
    const bf16* yb = (const bf16*)(F.ws + WS0_XN);
    const bf16* xbc = (const bf16*)((unsigned char*)F.out + DO_XBC);
    const int gw = F.vcu * NWAVES + F.wave, NGW = F.G * NWAVES;
    for (int m = gw; m < M; m += NGW) {
        f32x4 v[4]; float ss = 0.f;
#pragma unroll
        for (int j = 0; j < 4; ++j) { const int c = 4 * F.lane + 256 * j;
            const u32x2 zf = *(const u32x2*)(proj + (size_t)m * LDP0 + P0_Z + c), yf = *(const u32x2*)(proj + (size_t)m * LDP0 + P0_XBC + c), ybv = *(const u32x2*)(yb + (size_t)m * DM + c), xs = *(const u32x2*)(xbc + (size_t)m * CONVCH + c);
            const float dsk = F.d_skip[c >> 6];
            f32x4 y; y.x = bflo(yf.x) + bflo(ybv.x) + dsk * bflo(xs.x); y.y = bfhi(yf.x) + bfhi(ybv.x) + dsk * bfhi(xs.x); y.z = bflo(yf.y) + bflo(ybv.y) + dsk * bflo(xs.y); y.w = bfhi(yf.y) + bfhi(ybv.y) + dsk * bfhi(xs.y);
            y.x *= silu_f(bflo(zf.x)); y.y *= silu_f(bfhi(zf.x)); y.z *= silu_f(bflo(zf.y)); y.w *= silu_f(bfhi(zf.y));
            v[j] = y; ss += (y.x * y.x + y.y * y.y) + (y.z * y.z + y.w * y.w); }
        const float rstd = rsqrtf(wave_sum(ss) * (1.f / DM) + EPS);
#pragma unroll
        for (int j = 0; j < 4; ++j) { const int c = 4 * F.lane + 256 * j; const f32x4 g = *(const f32x4*)(F.ssd_norm + c); const f32x4 o = v[j] * rstd * g;
            u32x2 w; w.x = pk2(o.x, o.y); w.y = pk2(o.z, o.w); *(u32x2*)(proj + (size_t)m * LDP0 + P0_Z + c) = w; }
    }
}

__device__ __forceinline__ void mlstm_simple_item(Frame& F, int item, int dir) {
    const int b = item >> 3, h = item & 7;
    const int v = F.tid & 255, kh = F.tid >> 8;
    const bf16* proj = (const bf16*)(F.ws + WS1_PROJ);
    const float* gates = (const float*)(F.ws + WS1_GATES);
    bf16* H = (bf16*)(F.ws + WS1_H);
    LAS float* qs = (LAS float*)F.lds;
    LAS float* red = qs + 256;
    float C[64], nn[64];
#pragma unroll
    for (int j = 0; j < 64; ++j) { C[j] = 0.f; nn[j] = 0.f; }
    for (int tt = 0; tt < SEQ; ++tt) {
        const int tok = dir ? SEQ - 1 - tt : tt; const size_t row = (size_t)b * SEQ + tok;
        if (F.tid < 256) { const int which = F.tid >> 7, kk = F.tid & 127; qs[F.tid] = bf2f(proj[row * LDP1 + (which ? P1_K : P1_Q) + h * 128 + kk]); }
        const float ig = gates[row * 32 + (dir * 2 + 0) * 8 + h], fg = gates[row * 32 + (dir * 2 + 1) * 8 + h];
        const float fs = sigmoid_f(fg), ie = __expf(ig);
        const float vv = bf2f(proj[row * LDP1 + P1_V + h * 256 + v]);
        __syncthreads();
        float num = 0.f, den = 0.f;
#pragma unroll
        for (int j = 0; j < 64; ++j) { const float kq = qs[kh * 64 + j], kk = qs[128 + kh * 64 + j];
            C[j] = fs * C[j] + (ie * kk) * vv; nn[j] = fs * nn[j] + ie * kk; num += kq * C[j]; den += kq * nn[j]; }
        red[kh * 256 + v] = num; if (v == 0) red[512 + kh] = den;
        __syncthreads();
        if (kh == 0) {
            const float nt = red[v] + red[256 + v], dn = red[512] + red[513];
            float hv = nt / fmaxf(fabsf(dn), 1.f);
            bf16* hp = H + row * 2048 + h * 256 + v;
            if (dir) hv += bf2f(*hp);
            *hp = (bf16)f2bf(hv);
        }
    }
}
__device__ __forceinline__ void headstat_phase(Frame& F) {
    const bf16* H = (const bf16*)(F.ws + WS1_H); float* RS = (float*)(F.ws + WS1_RS);
    const int gw = F.vcu * NWAVES + F.wave, NGW = F.G * NWAVES;
    for (int m = gw; m < M; m += NGW) {
        float ss = 0.f;
#pragma unroll
        for (int c = 0; c < 4; ++c) { const u32x4 w = *(const u32x4*)(H + (size_t)m * 2048 + F.lane * 32 + 8 * c);
            const float a0 = bflo(w.x), a1 = bfhi(w.x), a2 = bflo(w.y), a3 = bfhi(w.y), a4 = bflo(w.z), a5 = bfhi(w.z), a6 = bflo(w.w), a7 = bfhi(w.w);
            ss += (a0 * a0 + a1 * a1) + (a2 * a2 + a3 * a3) + (a4 * a4 + a5 * a5) + (a6 * a6 + a7 * a7); }
        ss += __shfl_xor(ss, 1); ss += __shfl_xor(ss, 2); ss += __shfl_xor(ss, 4);
        if ((F.lane & 7) == 0) RS[(size_t)m * 8 + (F.lane >> 3)] = rsqrtf(ss * (1.f / 256.f) + EPS);
    }
}

__global__ void __launch_bounds__(NTHREADS, 2) mega_fwd(Args args) {
    extern __shared__ __attribute__((aligned(16))) unsigned char lds_raw[];
    Frame F;
    F.lds = (LAS unsigned char*)lds_raw;
    F.tid = threadIdx.x; F.lane = F.tid & 63; F.wave = __builtin_amdgcn_readfirstlane(F.tid >> 6);
    F.G = gridDim.x; { const int bx = blockIdx.x; F.vcu = (F.G % 8 == 0) ? (bx % 8) * (F.G / 8) + bx / 8 : bx; }
    F.x = args.in[0]; F.c = args.in[1]; F.ada_w = args.in[2]; F.ada_b = args.in[3]; F.norm_g = args.in[4]; F.mlp_w1 = args.in[5]; F.mlp_w2 = args.in[6];
    F.ab_w_in = args.in[7]; F.conv_w = args.in[8]; F.conv_b = args.in[9]; F.dt_bias = args.in[10]; F.a_log = args.in[11]; F.d_skip = args.in[12]; F.ssd_norm = args.in[13];
    F.rpb = args.in[14]; F.ab_w_out = args.in[15]; F.ml_w_in = args.in[16]; F.gate_b = args.in[17]; F.head_norm = args.in[18]; F.ml_w_out = args.in[19];
    F.out = args.out; F.ws = args.ws;
    unsigned char* ws = args.ws;
    float* mod = (float*)(ws + WS_MOD);
    volatile LAS unsigned* MISC = (volatile LAS unsigned*)(F.lds + LDS_BYTES - 64);
    if (F.tid < 16) MISC[F.tid] = 0u;
    __syncthreads();
    XcdBarrier bar; bar.bar = (unsigned*)(ws + WS_CTL) + 4096; bar.x = 0; bar.st = nullptr;
    if (MK_ONE_LAUNCH) bar = xcd_barrier_post((unsigned*)(ws + WS_CTL) + 4096, MISC + 8);
    const int lo = args.ph_lo, hi = args.ph_hi;
#define IN(k) (lo <= (k) && (k) < hi)
#define SEAM(k) do { if (IN(k) && IN((k) + 1)) xcd_barrier(bar); } while (0)

    if (IN(0)) {
        const TrJob jobs[7] = {
            {F.ab_w_in, 1024, ABIN, 0, 1024, (bf16*)(ws + W0_IN)},
            {F.ab_w_in, 1024, ABIN, 2592, 3072, (bf16*)(ws + W0_IN) + (size_t)1024 * 1024},
            {F.ab_w_in, 1024, ABIN, 1024, 1536, (bf16*)(ws + W0_IN) + (size_t)4096 * 1024},
            {F.ab_w_in, 1024, ABIN, 2560, 32, (bf16*)(ws + W0_DT)},
            {F.ab_w_out, 2048, 1024, 0, 1024, (bf16*)(ws + W0_OUT)},
            {F.mlp_w1, 1024, FF, 0, FF, (bf16*)(ws + W0_W1)},
            {F.mlp_w2, FF, 1024, 0, 1024, (bf16*)(ws + W0_W2)}};
        transpose_jobs(F, jobs);
        __syncthreads();
        mod_phase(F);
    }
    SEAM(0);
    if (IN(1)) rowpass<false, true>(F, F.x, nullptr, nullptr, nullptr, nullptr, F.norm_g + 0, mod + 0, mod + 1024, (bf16*)(ws + WS0_XN));
    SEAM(1);
    if (IN(2)) {
        EpiBf16 E{(bf16*)(ws + WS0_PROJ), LDP0, 0, 1.f};
        gemm_simple(F, (const bf16*)(ws + WS0_XN), DM, (const bf16*)(ws + W0_IN), M, 1024, DM, E);
        EpiBf16 Eq{(bf16*)(ws + WS0_PROJ) + P0_Q, LDP0, 1024, 0.125f};
        gemm_simple(F, (const bf16*)(ws + WS0_XN), DM, (const bf16*)(ws + W0_IN) + (size_t)1024 * 1024, M, 1024, DM, Eq);
        EpiBf16 Er{(bf16*)(ws + WS0_PROJ) + P0_K, LDP0, 0, 1.f};
        gemm_simple(F, (const bf16*)(ws + WS0_XN), DM, (const bf16*)(ws + W0_IN) + (size_t)2048 * 1024, M, LDP0 - 2048, DM, Er);
        EpiDt Ed{(float*)(ws + WS0_DT), F.dt_bias};
        gemm_simple(F, (const bf16*)(ws + WS0_XN), DM, (const bf16*)(ws + W0_DT), M, 32, DM, Ed);
    }
    SEAM(2);
    if (IN(3)) conv_phase(F);
    SEAM(3);
    if (IN(4)) {
        if ((int)blockIdx.x < 128) ssd_simple_item(F, blockIdx.x);
        else na_simple(F, blockIdx.x - 128, F.G - 128);
    }
    SEAM(4);
    if (IN(5)) gate_phase(F);
    SEAM(5);
    if (IN(6)) { EpiBf16 E{(bf16*)(ws + WS0_XN), DM, 0, 1.f};
        gemm_simple(F, (const bf16*)(ws + WS0_PROJ), LDP0, (const bf16*)(ws + W0_OUT), M, DM, 2048, E); }
    SEAM(6);
    if (IN(7)) rowpass<true, true>(F, F.x, (const bf16*)(ws + WS0_XN), mod + 2048, F.norm_g + 1024, F.out, F.norm_g + 2048, mod + 3072, mod + 4096, (bf16*)(ws + WS0_XN));
    SEAM(7);
    if (IN(8)) { EpiRelu2 E{(bf16*)(ws + WS0_U), FF}; gemm_simple(F, (const bf16*)(ws + WS0_XN), DM, (const bf16*)(ws + W0_W1), M, FF, DM, E); }
    SEAM(8);
    if (IN(9)) { EpiBf16 E{(bf16*)(ws + WS0_MLPOUT), DM, 0, 1.f}; gemm_simple(F, (const bf16*)(ws + WS0_U), FF, (const bf16*)(ws + W0_W2), M, DM, FF, E); }
    SEAM(9);
    if (IN(10)) {
        rowpass<true, true>(F, F.out, (const bf16*)(ws + WS0_MLPOUT), mod + 5120, F.norm_g + 3072, F.out, F.norm_g + 4096, mod + 4 * 6144, mod + 4 * 6144 + 1024, (bf16*)(ws + WS1_XN));
        const TrJob jobs[4] = {
            {F.ml_w_in, 1024, MLIN, 0, 4096, (bf16*)(ws + W1_QKV)},
            {F.ml_w_in, 1024, MLIN, 4096, 2048, (bf16*)(ws + W1_O)},
            {F.ml_w_in, 1024, MLIN, 6144, 32, (bf16*)(ws + W1_G)},
            {F.ml_w_out, 2048, 1024, 0, 1024, (bf16*)(ws + W1_OUT)}};
        transpose_jobs(F, jobs);
    }
    SEAM(10);
    if (IN(11)) {
        EpiBf16 E{(bf16*)(ws + WS1_PROJ), LDP1, 1024, 0.08838834764831845f};
        gemm_simple(F, (const bf16*)(ws + WS1_XN), DM, (const bf16*)(ws + W1_QKV), M, 4096, DM, E);
        EpiGates Eg{(float*)(ws + WS1_GATES), F.gate_b};
        gemm_simple(F, (const bf16*)(ws + WS1_XN), DM, (const bf16*)(ws + W1_G), M, 32, DM, Eg);
    }
    SEAM(11);
    if (IN(12)) { if ((int)blockIdx.x < 32) mlstm_simple_item(F, blockIdx.x, 0); }
    SEAM(12);
    if (IN(13)) { if ((int)blockIdx.x < 32) mlstm_simple_item(F, blockIdx.x, 1); }
    SEAM(13);
    if (IN(14)) headstat_phase(F);
    SEAM(14);
    if (IN(15)) { EpiOGate E{(bf16*)(ws + WS1_H), (const float*)(ws + WS1_RS), F.head_norm};
        gemm_simple(F, (const bf16*)(ws + WS1_XN), DM, (const bf16*)(ws + W1_O), M, 2048, DM, E); }
    SEAM(15);
    if (IN(16)) { EpiBf16 E{(bf16*)(ws + WS1_MIX), DM, 0, 1.f}; gemm_simple(F, (const bf16*)(ws + WS1_H), 2048, (const bf16*)(ws + W1_OUT), M, DM, 2048, E); }
    SEAM(16);
    if (IN(17)) {
        rowpass<true, true>(F, F.out, (const bf16*)(ws + WS1_MIX), mod + 4 * 6144 + 2048, F.norm_g + 4096 + 1024, F.out, F.norm_g + 4096 + 2048, mod + 4 * 6144 + 3072, mod + 4 * 6144 + 4096, (bf16*)(ws + WS1_XN));
        const TrJob jobs[2] = {
            {F.mlp_w1 + (size_t)1024 * FF, 1024, FF, 0, FF, (bf16*)(ws + W1_W1)},
            {F.mlp_w2 + (size_t)FF * 1024, FF, 1024, 0, 1024, (bf16*)(ws + W1_W2)}};
        transpose_jobs(F, jobs);
    }
    SEAM(17);
    if (IN(18)) { EpiRelu2 E{(bf16*)(ws + WS1_U), FF}; gemm_simple(F, (const bf16*)(ws + WS1_XN), DM, (const bf16*)(ws + W1_W1), M, FF, DM, E); }
    SEAM(18);
    if (IN(19)) { EpiBf16 E{(bf16*)(ws + WS1_MLPOUT), DM, 0, 1.f}; gemm_simple(F, (const bf16*)(ws + WS1_U), FF, (const bf16*)(ws + W1_W2), M, DM, FF, E); }
    SEAM(19);
    if (IN(20)) rowpass<true, false>(F, F.out, (const bf16*)(ws + WS1_MLPOUT), mod + 4 * 6144 + 5120, F.norm_g + 4096 + 3072, F.out, nullptr, nullptr, nullptr, nullptr);
#undef IN
#undef SEAM
}

extern "C" void kernel_launch(void* const* d_in, const int* in_sizes, int n_in, void* d_out, int out_size, void* d_ws, size_t ws_size, hipStream_t stream) {
    static int grid = 0;
    if (grid == 0) {
        if (n_in != 20 || out_size != M * DM || ws_size < WS_END) { fprintf(stderr, "kernel_launch: unexpected problem shape (n_in %d out %d ws %zu)\n", n_in, out_size, ws_size); grid = -1; return; }
        int dev = 0, cus = 0;
        if (hipGetDevice(&dev) != hipSuccess || hipDeviceGetAttribute(&cus, hipDeviceAttributeMultiprocessorCount, dev) != hipSuccess) { grid = -1; return; }
        if (hipFuncSetAttribute((const void*)mega_fwd, hipFuncAttributeMaxDynamicSharedMemorySize, LDS_BYTES) != hipSuccess) { fprintf(stderr, "kernel_launch: hipFuncSetAttribute failed\n"); grid = -1; return; }
        int per_cu = 0;
        if (hipOccupancyMaxActiveBlocksPerMultiprocessor(&per_cu, (const void*)mega_fwd, NTHREADS, LDS_BYTES) != hipSuccess || per_cu < 1) fprintf(stderr, "kernel_launch: occupancy query says %d\n", per_cu);
        (void)hipGetLastError();
        grid = cus;
    }
    if (grid < 0) return;
    (void)hipMemsetAsync((char*)d_ws + WS_CTL, 0, CTL_ZERO_BYTES, stream);
    Args a{};
    for (int i = 0; i < 20; ++i) a.in[i] = (const float*)d_in[i];
    a.out = (float*)d_out; a.ws = (unsigned char*)d_ws;
#if MK_ONE_LAUNCH
    a.ph_lo = 0; a.ph_hi = NPHASE;
    hipLaunchKernelGGL(mega_fwd, dim3(grid), dim3(NTHREADS), LDS_BYTES, stream, a);
#else
    for (int p = 0; p < NPHASE; ++p) { a.ph_lo = p; a.ph_hi = p + 1; hipLaunchKernelGGL(mega_fwd, dim3(grid), dim3(NTHREADS), LDS_BYTES, stream, a); }
#endif
}
```

```cpp
#include <hip/hip_runtime.h>
#include <cstdio>
#include <cstdint>

#define GAS __attribute__((address_space(1)))
#define LAS __attribute__((address_space(3)))
typedef unsigned short bf16;
typedef short bf16x8 __attribute__((ext_vector_type(8)));
typedef float f32x4 __attribute__((ext_vector_type(4)));
typedef unsigned u32x4 __attribute__((ext_vector_type(4)));
typedef unsigned u32x2 __attribute__((ext_vector_type(2)));

#ifndef USE_MLSTM_CHUNK
#define USE_MLSTM_CHUNK 1
#endif
#ifndef USE_SSD_CHUNK
#define USE_SSD_CHUNK 1
#endif
#ifndef USE_NA_MFMA
#define USE_NA_MFMA 1
#endif
#ifndef USE_PG8
#define USE_PG8 1
#endif
#ifndef MK_ONE_LAUNCH
#define MK_ONE_LAUNCH 1
#endif

constexpr int NWAVES = 8, NTHREADS = 512;
constexpr int BATCH = 4, SEQ = 4096, DM = 1024, M = BATCH * SEQ, FF = 4096;
constexpr float EPS = 1e-6f;
constexpr int SH = 16, SP = 64, SN = 128, CONVCH = 1536, ABIN = 5664;
constexpr int LDP0 = 5632, P0_Z = 0, P0_Q = 1024, P0_K = 2048, P0_V = 3072, P0_XBC = 4096;
constexpr int MH = 8, MDK = 128, MDV = 256, MLIN = 6176, LDP1 = 4096, P1_Q = 0, P1_K = 1024, P1_V = 2048;
constexpr int NPHASE = 21;

constexpr size_t MiB = 1u << 20;
constexpr size_t WS_CTL = 0, CTL_ZERO_BYTES = 1 * MiB;
constexpr size_t WS_MOD = 1 * MiB;
constexpr size_t W0_IN = 2 * MiB, W0_DT = 13 * MiB, W0_OUT = 14 * MiB, W0_W1 = 18 * MiB, W0_W2 = 26 * MiB;
constexpr size_t WS0_XN = 36 * MiB, WS0_DT = 68 * MiB, WS0_PROJ = 70 * MiB, WS0_U = 70 * MiB, WS0_MLPOUT = 198 * MiB;
constexpr size_t W1_QKV = 2 * MiB, W1_O = 10 * MiB, W1_G = 14 * MiB, W1_OUT = 15 * MiB, W1_W1 = 2 * MiB, W1_W2 = 10 * MiB;
constexpr size_t WS1_GATES = 19 * MiB, WS1_XN = 21 * MiB, WS1_PROJ = 53 * MiB, WS1_H = 181 * MiB, WS1_RS = 245 * MiB;
constexpr size_t WS1_MIX = 53 * MiB, WS1_U = 53 * MiB, WS1_MLPOUT = 181 * MiB;
constexpr size_t WS_END = 256 * MiB;
constexpr size_t DO_XBC = 0;

constexpr int LDS_BYTES = 163840;

__device__ __forceinline__ float bf2f(unsigned v) { return __uint_as_float(v << 16); }
__device__ __forceinline__ unsigned f2bf(float f) { unsigned u = __float_as_uint(f); return (u + 0x7fffu + ((u >> 16) & 1u)) >> 16; }
__device__ __forceinline__ unsigned pk2(float lo, float hi) { return f2bf(lo) | (f2bf(hi) << 16); }
__device__ __forceinline__ float bflo(unsigned w) { return __uint_as_float(w << 16); }
__device__ __forceinline__ float bfhi(unsigned w) { return __uint_as_float(w & 0xffff0000u); }
__device__ __forceinline__ float wave_sum(float v) {
#pragma unroll
    for (int o = 1; o < 64; o <<= 1) v += __shfl_xor(v, o);
    return v;
}
__device__ __forceinline__ float silu_f(float x) { return x / (1.f + __expf(-x)); }
__device__ __forceinline__ float sigmoid_f(float x) { return 1.f / (1.f + __expf(-x)); }
__device__ __forceinline__ float softplus_f(float x) { return x > 20.f ? x : log1pf(__expf(x)); }

#define XB_TMO      128
#define XB_XCNT(j)  (256  + 64 * (j))
#define XB_XSUB(j)  (1280 + 64 * (j))
#define XB_XGEN(j)  (2304 + 64 * (j))
#define XB_TOP      3328
#define XB_TOPGEN   3392
#define XCD_BAR_WORDS 3456
#define XB_SPIN_CAP (1u << 22)
__device__ __forceinline__ unsigned xb_ld(unsigned* p)              { return __hip_atomic_load(p, __ATOMIC_RELAXED, __HIP_MEMORY_SCOPE_AGENT); }
__device__ __forceinline__ unsigned xb_add(unsigned* p, unsigned v) { return __hip_atomic_fetch_add(p, v, __ATOMIC_RELAXED, __HIP_MEMORY_SCOPE_AGENT); }
__device__ __forceinline__ unsigned xb_xcc_id() { return (unsigned)__builtin_amdgcn_s_getreg((3 << 11) | 20) & 0xFu; }
#define XB_SPIN(cond, bar) do { unsigned _sp = 0; while (cond) { __builtin_amdgcn_s_sleep(1); \
    if ((++_sp & 255u) == 0u) { if (xb_ld(&(bar)[XB_TMO])) break; if (_sp > XB_SPIN_CAP) { atomicAdd(&(bar)[XB_TMO], 1u); break; } } } } while (0)
struct XcdBarrier { unsigned* bar; unsigned x; volatile LAS unsigned* st; };
__device__ __forceinline__ XcdBarrier xcd_barrier_post(unsigned* bar, volatile LAS unsigned* st) {
    XcdBarrier b; b.bar = bar; b.x = xb_xcc_id(); b.st = st;
    if (threadIdx.x == 0) (void)xb_add(&bar[XB_XCNT(b.x)], 1u);
    return b;
}
__device__ __forceinline__ void xcd_barrier_complete(unsigned* bar, unsigned x, unsigned& nloc, unsigned& nx) {
    const unsigned G = gridDim.x * gridDim.y * gridDim.z;
    unsigned sum, cnt, mine, sp = 0u;
    for (;;) {
        sum = 0u; cnt = 0u; mine = 0u;
#pragma unroll
        for (unsigned j = 0; j < 16; ++j) { const unsigned c = xb_ld(&bar[XB_XCNT(j)]); sum += c; cnt += (c > 0u) ? 1u : 0u; mine = (j == x) ? c : mine; }
        if (sum == G) break;
        __builtin_amdgcn_s_sleep(1);
        if ((++sp & 255u) == 0u) { if (xb_ld(&bar[XB_TMO])) break; if (sp > XB_SPIN_CAP) { atomicAdd(&bar[XB_TMO], 1u); break; } }
    }
    nloc = mine > 0u ? mine : 1u; nx = cnt > 0u ? cnt : 1u;
}
__device__ __forceinline__ void xcd_barrier(const XcdBarrier& b) {
    asm volatile("s_waitcnt vmcnt(0)" ::: "memory");
    __syncthreads();
    if (threadIdx.x == 0) {
        unsigned* bar = b.bar;
        __builtin_amdgcn_s_waitcnt(0);
        unsigned nloc = b.st[0], nx = b.st[1];
        if (nloc == 0u) { xcd_barrier_complete(bar, b.x, nloc, nx); b.st[0] = nloc; b.st[1] = nx; }
        const unsigned old = xb_add(&bar[XB_XSUB(b.x)], 1u);
        const unsigned gen = old / nloc;
        if (old + 1u == (gen + 1u) * nloc) {
            __builtin_amdgcn_fence(__ATOMIC_RELEASE, "agent");
            asm volatile("s_waitcnt vmcnt(0)" ::: "memory");
            const unsigned og = xb_add(&bar[XB_TOP], 1u);
            const unsigned tg = og / nx;
            if (og + 1u == (tg + 1u) * nx) xb_add(&bar[XB_TOPGEN], 1u);
            else XB_SPIN(xb_ld(&bar[XB_TOPGEN]) == tg, bar);
            __builtin_amdgcn_fence(__ATOMIC_ACQUIRE, "agent");
            xb_add(&bar[XB_XGEN(b.x)], 1u);
            asm volatile("s_waitcnt vmcnt(0)" ::: "memory");
        } else {
            XB_SPIN(xb_ld(&bar[XB_XGEN(b.x)]) == gen, bar);
            __builtin_amdgcn_fence(__ATOMIC_ACQUIRE, "agent");
            asm volatile("s_waitcnt vmcnt(0)" ::: "memory");
        }
    }
    __syncthreads();
}

struct Args { const float* in[20]; float* out; unsigned char* ws; int ph_lo, ph_hi; };
struct Frame {
    LAS unsigned char* lds;
    int tid, lane, wave, G, vcu;
    const float *x, *c, *ada_w, *ada_b, *norm_g, *mlp_w1, *mlp_w2, *ab_w_in, *conv_w, *conv_b, *dt_bias, *a_log, *d_skip, *ssd_norm, *rpb, *ab_w_out,
                *ml_w_in, *gate_b, *head_norm, *ml_w_out;
    float* out; unsigned char* ws;
};

__device__ __forceinline__ bool phase_begin(Frame& F) { int t_ = threadIdx.x; asm volatile("" : "+v"(t_)); F.tid = t_; F.lane = t_ & 63; return true; }
__device__ __forceinline__ void transpose_item(const float* W, int K, int ldw, int c0, int ncols, bf16* WT, LAS float* scr, int item, int lane) {
    const int nblk = ncols / 32, kb = item / nblk, nb = item % nblk, k0 = 64 * kb, n0 = 32 * nb;
#pragma unroll 8
    for (int i = 0; i < 32; ++i) { const int kk = 2 * i + (lane >> 5); scr[kk * 33 + (lane & 31)] = W[(size_t)(k0 + kk) * ldw + c0 + n0 + (lane & 31)]; }
    asm volatile("s_waitcnt lgkmcnt(0)" ::: "memory");
    const int c = lane & 7;
#pragma unroll
    for (int j = 0; j < 4; ++j) { const int n = (lane >> 3) + 8 * j; const LAS float* s = scr + (8 * c) * 33 + n;
        u32x4 o; o.x = pk2(s[0 * 33], s[1 * 33]); o.y = pk2(s[2 * 33], s[3 * 33]); o.z = pk2(s[4 * 33], s[5 * 33]); o.w = pk2(s[6 * 33], s[7 * 33]);
        *(u32x4*)(WT + (size_t)(n0 + n) * K + k0 + 8 * c) = o; }
    asm volatile("s_waitcnt lgkmcnt(0)" ::: "memory");
}
struct TrJob { const float* W; int K, ldw, c0, ncols; bf16* WT; };
template <int NJ> __device__ __forceinline__ void transpose_jobs(Frame& F, const TrJob (&jobs)[NJ]) {
    LAS float* scr = (LAS float*)(F.lds + F.wave * 16384);
    const int gw = F.vcu * NWAVES + F.wave, NGW = F.G * NWAVES;
    int base = 0;
#pragma unroll
    for (int j = 0; j < NJ; ++j) {
        const int nitems = (jobs[j].K / 64) * (jobs[j].ncols / 32);
        int first = gw - (base % NGW); if (first < 0) first += NGW;
        for (int it = first; it < nitems; it += NGW) transpose_item(jobs[j].W, jobs[j].K, jobs[j].ldw, jobs[j].c0, jobs[j].ncols, jobs[j].WT, scr, it, F.lane);
        base += nitems;
    }
}

__device__ __forceinline__ void mod_phase(Frame& F) {
    float* mod = (float*)(F.ws + WS_MOD);
    LAS float* red = (LAS float*)F.lds;
    for (int item = blockIdx.x; item < 2 * 96; item += F.G) {
        const int l = item / 96, cg = item % 96, col = cg * 64 + F.lane, kg = F.wave;
        float acc0 = 0.f, acc1 = 0.f, acc2 = 0.f, acc3 = 0.f;
        const float* w = F.ada_w + ((size_t)l * 1024 + kg * 128) * 6144 + col;
        const float* cc = F.c + kg * 128;
#pragma unroll 4
        for (int k = 0; k < 128; ++k) {
            const float wv = w[(size_t)k * 6144];
            acc0 += silu_f(cc[k]) * wv; acc1 += silu_f(cc[1024 + k]) * wv; acc2 += silu_f(cc[2048 + k]) * wv; acc3 += silu_f(cc[3072 + k]) * wv;
        }
        red[(kg * 4 + 0) * 64 + F.lane] = acc0; red[(kg * 4 + 1) * 64 + F.lane] = acc1; red[(kg * 4 + 2) * 64 + F.lane] = acc2; red[(kg * 4 + 3) * 64 + F.lane] = acc3;
        __syncthreads();
        if (F.tid < 256) { const int b = F.tid >> 6, ln = F.tid & 63; float s = 0.f;
#pragma unroll
            for (int g = 0; g < 8; ++g) s += red[(g * 4 + b) * 64 + ln];
            mod[((size_t)l * 4 + b) * 6144 + cg * 64 + ln] = s + F.ada_b[l * 6144 + cg * 64 + ln]; }
        __syncthreads();
    }
}

template <bool HAS_MIX, bool HAS_XN>
__device__ __forceinline__ void rowpass(Frame& F, const float* xin, const bf16* mix, const float* gate, const float* ng_mix, float* xout,
                                        const float* ng_x, const float* sh, const float* sc, bf16* xn) {
    const int gw = F.vcu * NWAVES + F.wave, NGW = F.G * NWAVES;
    for (int m = gw; m < M; m += NGW) {
        const int b = m / SEQ;
        f32x4 v[4];
#pragma unroll
        for (int j = 0; j < 4; ++j) v[j] = *(const f32x4*)(xin + (size_t)m * DM + 4 * F.lane + 256 * j);
        if (HAS_MIX) {
            f32x4 mv[4]; float ss = 0.f;
#pragma unroll
            for (int j = 0; j < 4; ++j) { const u32x2 w = *(const u32x2*)(mix + (size_t)m * DM + 4 * F.lane + 256 * j);
                mv[j] = (f32x4){bflo(w.x), bfhi(w.x), bflo(w.y), bfhi(w.y)}; ss += (mv[j].x * mv[j].x + mv[j].y * mv[j].y) + (mv[j].z * mv[j].z + mv[j].w * mv[j].w); }
            const float rstd = rsqrtf(wave_sum(ss) * (1.f / DM) + EPS);
#pragma unroll
            for (int j = 0; j < 4; ++j) { const int c = 4 * F.lane + 256 * j; const f32x4 g = *(const f32x4*)(gate + (size_t)b * 6144 + c), ng = *(const f32x4*)(ng_mix + c);
                v[j] = v[j] + g * (mv[j] * rstd * ng); *(f32x4*)(xout + (size_t)m * DM + c) = v[j]; }
        }
        if (HAS_XN) {
            float ss = 0.f;
#pragma unroll
            for (int j = 0; j < 4; ++j) ss += (v[j].x * v[j].x + v[j].y * v[j].y) + (v[j].z * v[j].z + v[j].w * v[j].w);
            const float rstd = rsqrtf(wave_sum(ss) * (1.f / DM) + EPS);
#pragma unroll
            for (int j = 0; j < 4; ++j) { const int c = 4 * F.lane + 256 * j; const f32x4 ng = *(const f32x4*)(ng_x + c), s1 = *(const f32x4*)(sc + (size_t)b * 6144 + c), s0 = *(const f32x4*)(sh + (size_t)b * 6144 + c);
                const f32x4 o = (v[j] * rstd * ng) * (s1 + 1.f) + s0; u32x2 w; w.x = pk2(o.x, o.y); w.y = pk2(o.z, o.w);
                *(u32x2*)(xn + (size_t)m * DM + c) = w; }
        }
    }
}

template <class Epi>
__device__ __forceinline__ void gemm_simple(Frame& F, const bf16* A, int lda, const bf16* Bt, int Mr, int N, int K, const Epi& E) {
    const int gw = F.vcu * NWAVES + F.wave, NGW = F.G * NWAVES;
    const int tn_n = N / 32, ntiles = (Mr / 32) * tn_n;
    const int fr = F.lane & 15, fq = F.lane >> 4;
    for (int t = gw; t < ntiles; t += NGW) {
        const int tm = t / tn_n, tn = t % tn_n, m0 = tm * 32, n0 = tn * 32;
        f32x4 acc[2][2];
#pragma unroll
        for (int i = 0; i < 2; ++i)
#pragma unroll
            for (int j = 0; j < 2; ++j) acc[i][j] = (f32x4){0.f, 0.f, 0.f, 0.f};
        const bf16* ap = A + (size_t)(m0 + fr) * lda + fq * 8;
        const bf16* bp = Bt + (size_t)(n0 + fr) * K + fq * 8;
#pragma unroll 2
        for (int k0 = 0; k0 < K; k0 += 32) {
            const bf16x8 a0 = *(const bf16x8*)(ap + k0), a1 = *(const bf16x8*)(ap + (size_t)16 * lda + k0);
            const bf16x8 b0 = *(const bf16x8*)(bp + k0), b1 = *(const bf16x8*)(bp + (size_t)16 * K + k0);
            acc[0][0] = __builtin_amdgcn_mfma_f32_16x16x32_bf16(b0, a0, acc[0][0], 0, 0, 0);
            acc[0][1] = __builtin_amdgcn_mfma_f32_16x16x32_bf16(b1, a0, acc[0][1], 0, 0, 0);
            acc[1][0] = __builtin_amdgcn_mfma_f32_16x16x32_bf16(b0, a1, acc[1][0], 0, 0, 0);
            acc[1][1] = __builtin_amdgcn_mfma_f32_16x16x32_bf16(b1, a1, acc[1][1], 0, 0, 0);
        }
#pragma unroll
        for (int i = 0; i < 2; ++i)
#pragma unroll
            for (int j = 0; j < 2; ++j) E.put4(m0 + 16 * i + fr, n0 + 16 * j + 4 * fq, acc[i][j]);
    }
}
struct EpiBf16 {
    bf16* O; int ldc; int sc0, sc1; float scale;
    __device__ __forceinline__ void put4(int row, int col, f32x4 v) const {
        if (col >= sc0 && col < sc1) v = v * scale;
        u32x2 w; w.x = pk2(v.x, v.y); w.y = pk2(v.z, v.w); *(u32x2*)(O + (size_t)row * ldc + col) = w; }
};
struct EpiRelu2 {
    bf16* O; int ldc;
    __device__ __forceinline__ void put4(int row, int col, f32x4 v) const {
        v.x = fmaxf(v.x, 0.f); v.y = fmaxf(v.y, 0.f); v.z = fmaxf(v.z, 0.f); v.w = fmaxf(v.w, 0.f); v = v * v;
        u32x2 w; w.x = pk2(v.x, v.y); w.y = pk2(v.z, v.w); *(u32x2*)(O + (size_t)row * ldc + col) = w; }
};
struct EpiDt {
    float* O; const float* bias;
    __device__ __forceinline__ void put4(int row, int col, f32x4 v) const {
        const f32x4 b = *(const f32x4*)(bias + col); f32x4 o;
        o.x = softplus_f(v.x + b.x); o.y = softplus_f(v.y + b.y); o.z = softplus_f(v.z + b.z); o.w = softplus_f(v.w + b.w);
        *(f32x4*)(O + (size_t)row * 32 + col) = o; }
};
struct EpiGates {
    float* O; const float* bias;
    __device__ __forceinline__ void put4(int row, int col, f32x4 v) const { *(f32x4*)(O + (size_t)row * 32 + col) = v + *(const f32x4*)(bias + col); }
};
struct EpiOGate {
    bf16* H; const float* RS; const float* hg;
    __device__ __forceinline__ void put4(int row, int col, f32x4 v) const {
        bf16* p = H + (size_t)row * 2048 + col; const u32x2 w = *(const u32x2*)p; const float rs = RS[(size_t)row * 8 + (col >> 8)]; const f32x4 g = *(const f32x4*)(hg + col);
        f32x4 o; o.x = sigmoid_f(v.x) * bflo(w.x) * rs * g.x; o.y = sigmoid_f(v.y) * bfhi(w.x) * rs * g.y; o.z = sigmoid_f(v.z) * bflo(w.y) * rs * g.z; o.w = sigmoid_f(v.w) * bfhi(w.y) * rs * g.w;
        u32x2 r; r.x = pk2(o.x, o.y); r.y = pk2(o.z, o.w); *(u32x2*)p = r; }
};

namespace pg8 {
constexpr int BM = 256, BK = 64, HALF = 128, HTB = HALF * BK * 2, STAGE_BYTES = 8 * HTB, NXCD = 8, WGM = 8;
__host__ __device__ __forceinline__ int lds_byte(int r, int c) { const int st = (r >> 4) * 2 + (c >> 5), rr = r & 15, cc = c & 31, ob = rr * 64 + cc * 2; return st * 1024 + (ob ^ (((ob >> 9) & 1) << 5)); }
__host__ __device__ __forceinline__ void stage_rc(int b, int& R, int& C) { const int st = b / 1024, sb = b % 1024, swz = sb ^ (((sb >> 9) & 1) << 5); R = (st >> 1) * 16 + swz / 64; C = (st & 1) * 32 + (swz % 64) / 2; }
struct Unit { int pm, pn; };
struct Gemm { const bf16* A; int lda; const bf16* Bt; int M, N, K; };
struct StaticOrder {
    int nM, nN, nwg, G, c;
    __host__ __device__ void init(int M_, int N_, int G_, int c_) { nM = M_ / BM; nN = N_ / BM; nwg = nM * nN; G = G_; c = c_; }
    __host__ __device__ bool next(int i, Unit& u) const {
        const long L = (long)i * G + c; if (L >= nwg) return false;
        int wgid = (int)L; { const int q = nwg / NXCD, r = nwg % NXCD, xcd = wgid % NXCD, off = wgid / NXCD; wgid = (xcd < r ? xcd * (q + 1) : r * (q + 1) + (xcd - r) * q) + off; }
        const int nig = WGM * nN, gid = wgid / nig, fm = gid * WGM, gsz = (nM - fm) < WGM ? (nM - fm) : WGM;
        u.pm = fm + ((wgid % nig) % gsz); u.pn = (wgid % nig) / gsz; return true;
    }
};
template <class Epi, bool ALIGN_EPI = true>
__device__ __forceinline__ void gemm_phase(LAS unsigned char* lds, const Gemm g, const StaticOrder& S, const Epi& E) {
    const int tid = threadIdx.x, wid = __builtin_amdgcn_readfirstlane(tid >> 6), lane = tid & 63, wr = wid >> 2, wc = wid & 3, fr = lane & 15, fq = lane >> 4;
    const int K = g.K, nt = K / BK, lda = g.lda;
    unsigned voffA[2], voffB[2];
#pragma unroll
    for (int i = 0; i < 2; ++i) { int R, C; stage_rc(tid * 16 + i * 8192, R, C); voffA[i] = (unsigned)(R * lda + C) * 2u; voffB[i] = (unsigned)(R * K + C) * 2u; }
    const size_t kstep = (size_t)(BK * 2);
    const size_t hstepA = (size_t)HALF * lda * 2, hstepB = (size_t)HALF * K * 2;
    const size_t tstepA = 2 * hstepA, tstepB = 2 * hstepB;
    const unsigned ldsw = (unsigned)wid * 1024u;
    const int aoff = lds_byte(wr * 64 + fr, fq * 8), boff = lds_byte(wc * 32 + fr, fq * 8);
#define PG8_SA(b, h) (((b) * 2 + (h)) * HTB)
#define PG8_SB(b, h) ((4 + (b) * 2 + (h)) * HTB)
#define PG8_STAGE(bufoff, gbase, voff) do { _Pragma("unroll") for (int _i = 0; _i < 2; ++_i) \
        __builtin_amdgcn_global_load_lds((const unsigned*)((const char*)(gbase) + (voff)[_i]), (LAS unsigned*)(lds + (bufoff) + ldsw + _i * 8192), 16, 0, 0); } while (0)
#define PG8_LDA(dst, b, h) do { _Pragma("unroll") for (int m = 0; m < 4; ++m) _Pragma("unroll") for (int k = 0; k < 2; ++k) dst[m][k] = *(const LAS bf16x8*)(lds + PG8_SA(b, h) + aoff + m * 2048 + k * 1024); } while (0)
#define PG8_LDB(dst, b, h) do { _Pragma("unroll") for (int n = 0; n < 2; ++n) _Pragma("unroll") for (int k = 0; k < 2; ++k) dst[n][k] = *(const LAS bf16x8*)(lds + PG8_SB(b, h) + boff + n * 2048 + k * 1024); } while (0)
#define PG8_MMA(ai, bj, At, Bt) do { __builtin_amdgcn_s_setprio(1); _Pragma("unroll") for (int m = 0; m < 4; ++m) _Pragma("unroll") for (int n = 0; n < 2; ++n) _Pragma("unroll") for (int k = 0; k < 2; ++k) \
        acc[ai][bj][m][n] = __builtin_amdgcn_mfma_f32_16x16x32_bf16(Bt[n][k], At[m][k], acc[ai][bj][m][n], 0, 0, 0); __builtin_amdgcn_s_setprio(0); } while (0)
#define PG8_WAIT_V(n) asm volatile("s_waitcnt vmcnt(" #n ")" ::: "memory")
#define PG8_WAIT_L(n) asm volatile("s_waitcnt lgkmcnt(" #n ")" ::: "memory")
#define PG8_BAR __builtin_amdgcn_s_barrier()
#define PG8_SCHED __builtin_amdgcn_sched_barrier(0)
    Unit cur, nxt; int ui = 0;
    if (!S.next(0, cur)) return;
    f32x4 acc[2][2][4][2];
#pragma unroll
    for (int a = 0; a < 2; ++a)
#pragma unroll
        for (int b = 0; b < 2; ++b)
#pragma unroll
            for (int m = 0; m < 4; ++m)
#pragma unroll
                for (int n = 0; n < 2; ++n) acc[a][b][m][n] = (f32x4){0.f, 0.f, 0.f, 0.f};
    bf16x8 At[4][2], B0[2][2], B1[2][2];
    const char* cA = (const char*)g.A + (size_t)cur.pm * tstepA; const char* cB = (const char*)g.Bt + (size_t)cur.pn * tstepB;
    PG8_STAGE(PG8_SB(0, 0), cB, voffB); PG8_STAGE(PG8_SB(0, 1), cB + hstepB, voffB); PG8_STAGE(PG8_SA(0, 0), cA, voffA); PG8_STAGE(PG8_SA(0, 1), cA + hstepA, voffA);
    if (wr == 1) PG8_BAR;
    PG8_WAIT_V(2); PG8_BAR;
    PG8_STAGE(PG8_SB(1, 0), cB + kstep, voffB); PG8_STAGE(PG8_SA(1, 0), cA + kstep, voffA); PG8_STAGE(PG8_SB(1, 1), cB + hstepB + kstep, voffB);
    PG8_WAIT_V(6); PG8_BAR;
    for (;;) {
        const bool has_next = S.next(ui + 1, nxt);
        const char* nA = has_next ? (const char*)g.A + (size_t)nxt.pm * tstepA : cA; const char* nB = has_next ? (const char*)g.Bt + (size_t)nxt.pn * tstepB : cB;
        for (int t = 0; t < nt; t += 2) {
            const bool last = (t == nt - 2);
            const char* a1 = cA + (size_t)(t + 1) * kstep;
            const char* a2 = last ? nA : cA + (size_t)(t + 2) * kstep; const char* b2 = last ? nB : cB + (size_t)(t + 2) * kstep;
            const char* a3 = a2 + kstep; const char* b3 = b2 + kstep;
            PG8_LDB(B0, 0, 0); PG8_LDB(B1, 0, 1); PG8_SCHED; PG8_LDA(At, 0, 0); PG8_STAGE(PG8_SA(1, 1), a1 + hstepA, voffA);
            PG8_WAIT_V(8); PG8_WAIT_L(0); PG8_BAR; PG8_MMA(0, 0, At, B0); PG8_MMA(0, 1, At, B1); PG8_BAR; PG8_SCHED;
            PG8_LDA(At, 0, 1); PG8_STAGE(PG8_SB(0, 0), b2, voffB); PG8_STAGE(PG8_SB(0, 1), b2 + hstepB, voffB); PG8_STAGE(PG8_SA(0, 0), a2, voffA);
            PG8_WAIT_V(8); PG8_WAIT_L(0); PG8_BAR; PG8_MMA(1, 0, At, B0); PG8_MMA(1, 1, At, B1); PG8_BAR; PG8_SCHED;
            PG8_LDB(B0, 1, 0); PG8_LDB(B1, 1, 1); PG8_SCHED; PG8_LDA(At, 1, 0); PG8_STAGE(PG8_SA(0, 1), a2 + hstepA, voffA);
            PG8_WAIT_V(8); PG8_WAIT_L(0); PG8_BAR; PG8_MMA(0, 0, At, B0); PG8_MMA(0, 1, At, B1); PG8_BAR; PG8_SCHED;
            PG8_LDA(At, 1, 1); PG8_STAGE(PG8_SB(1, 0), b3, voffB); PG8_STAGE(PG8_SB(1, 1), b3 + hstepB, voffB); PG8_STAGE(PG8_SA(1, 0), a3, voffA);
            PG8_WAIT_V(8); PG8_WAIT_L(0); PG8_BAR; PG8_MMA(1, 0, At, B0); PG8_MMA(1, 1, At, B1); PG8_BAR; PG8_SCHED;
        }
        if constexpr (ALIGN_EPI) { if (wr == 0) PG8_BAR; }
        {
            const int row0 = cur.pm * BM + wr * 64 + fr, col0 = cur.pn * BM + wc * 32 + 4 * fq;
#pragma unroll
            for (int ai = 0; ai < 2; ++ai)
#pragma unroll
                for (int m = 0; m < 4; ++m)
#pragma unroll
                    for (int bj = 0; bj < 2; ++bj)
#pragma unroll
                        for (int n = 0; n < 2; ++n) E.put4(row0 + ai * HALF + m * 16, col0 + bj * HALF + n * 16, acc[ai][bj][m][n]);
        }
        if (!has_next) break;
#pragma unroll
        for (int a = 0; a < 2; ++a)
#pragma unroll
            for (int b = 0; b < 2; ++b)
#pragma unroll
                for (int m = 0; m < 4; ++m)
#pragma unroll
                    for (int n = 0; n < 2; ++n) acc[a][b][m][n] = (f32x4){0.f, 0.f, 0.f, 0.f};
        cur = nxt; cA = nA; cB = nB; ++ui;
        if constexpr (ALIGN_EPI) { if (wr == 1) PG8_BAR; }
    }
    PG8_WAIT_V(0);
    if constexpr (!ALIGN_EPI) { if (wr == 0) PG8_BAR; }
    PG8_BAR;
#undef PG8_SA
#undef PG8_SB
#undef PG8_STAGE
#undef PG8_LDA
#undef PG8_LDB
#undef PG8_MMA
#undef PG8_WAIT_V
#undef PG8_WAIT_L
#undef PG8_BAR
#undef PG8_SCHED
}
}
template <class Epi>
__device__ __forceinline__ void gemm_big(Frame& F, const bf16* A, int lda, const bf16* Bt, int Mr, int N, int K, const Epi& E) {
#if USE_PG8
    pg8::Gemm g{A, lda, Bt, Mr, N, K}; pg8::StaticOrder S; S.init(Mr, N, F.G, (int)blockIdx.x);
    pg8::gemm_phase<Epi, true>(F.lds, g, S, E);
    __syncthreads();
#else
    gemm_simple(F, A, lda, Bt, Mr, N, K, E);
#endif
}

__device__ __forceinline__ void conv_phase(Frame& F) {
    const bf16* proj = (const bf16*)(F.ws + WS0_PROJ);
    bf16* xbcp = (bf16*)((unsigned char*)F.out + DO_XBC);
    const size_t total = (size_t)M * (CONVCH / 8), stride = (size_t)F.G * NTHREADS;
    for (size_t i = (size_t)blockIdx.x * NTHREADS + F.tid; i < total; i += stride) {
        const int row = (int)(i / (CONVCH / 8)), cg = (int)(i % (CONVCH / 8)), c0 = cg * 8, t = row % SEQ;
        float acc[8];
#pragma unroll
        for (int e = 0; e < 8; ++e) acc[e] = F.conv_b[c0 + e];
#pragma unroll
        for (int j = 0; j < 5; ++j) {
            const int tt = t + j - 2;
            if (tt >= 0 && tt < SEQ) {
                const u32x4 w = *(const u32x4*)(proj + (size_t)(row + j - 2) * LDP0 + P0_XBC + c0);
                const f32x4 k0 = *(const f32x4*)(F.conv_w + j * CONVCH + c0), k1 = *(const f32x4*)(F.conv_w + j * CONVCH + c0 + 4);
                acc[0] += bflo(w.x) * k0.x; acc[1] += bfhi(w.x) * k0.y; acc[2] += bflo(w.y) * k0.z; acc[3] += bfhi(w.y) * k0.w;
                acc[4] += bflo(w.z) * k1.x; acc[5] += bfhi(w.z) * k1.y; acc[6] += bflo(w.w) * k1.z; acc[7] += bfhi(w.w) * k1.w;
            }
        }
        u32x4 o; o.x = pk2(silu_f(acc[0]), silu_f(acc[1])); o.y = pk2(silu_f(acc[2]), silu_f(acc[3])); o.z = pk2(silu_f(acc[4]), silu_f(acc[5])); o.w = pk2(silu_f(acc[6]), silu_f(acc[7]));
        *(u32x4*)(xbcp + (size_t)row * CONVCH + c0) = o;
    }
}

#if !USE_SSD_CHUNK
__device__ __forceinline__ void ssd_simple_item(Frame& F, int item) {
    const int dir = item >> 6, b = (item >> 4) & 3, h = item & 15, g = h >> 3;
    const int p = F.tid >> 3, nq = F.tid & 7;
    const float a = -__expf(F.a_log[dir * 16 + h]);
    const bf16* xbc = (const bf16*)((unsigned char*)F.out + DO_XBC);
    const float* dtv = (const float*)(F.ws + WS0_DT);
    bf16* Y; int ldy;
    if (dir == 0) { Y = (bf16*)(F.ws + WS0_PROJ) + P0_XBC; ldy = LDP0; } else { Y = (bf16*)(F.ws + WS0_XN); ldy = DM; }
    float S[16];
#pragma unroll
    for (int j = 0; j < 16; ++j) S[j] = 0.f;
    for (int tt = 0; tt < SEQ; ++tt) {
        const int tok = dir ? SEQ - 1 - tt : tt; const size_t row = (size_t)b * SEQ + tok;
        const float dt = dtv[row * 32 + dir * 16 + h];
        const float dA = __expf(dt * a);
        const float xv = bf2f(xbc[row * CONVCH + h * 64 + p]) * dt;
        const u32x4* Bp = (const u32x4*)(xbc + row * CONVCH + 1024 + g * 128 + nq * 16); const u32x4 b0 = Bp[0], b1 = Bp[1];
        const u32x4* Cp = (const u32x4*)(xbc + row * CONVCH + 1280 + g * 128 + nq * 16); const u32x4 c0 = Cp[0], c1 = Cp[1];
        const float Bv[16] = {bflo(b0.x), bfhi(b0.x), bflo(b0.y), bfhi(b0.y), bflo(b0.z), bfhi(b0.z), bflo(b0.w), bfhi(b0.w), bflo(b1.x), bfhi(b1.x), bflo(b1.y), bfhi(b1.y), bflo(b1.z), bfhi(b1.z), bflo(b1.w), bfhi(b1.w)};
        const float Cv[16] = {bflo(c0.x), bfhi(c0.x), bflo(c0.y), bfhi(c0.y), bflo(c0.z), bfhi(c0.z), bflo(c0.w), bfhi(c0.w), bflo(c1.x), bfhi(c1.x), bflo(c1.y), bfhi(c1.y), bflo(c1.z), bfhi(c1.z), bflo(c1.w), bfhi(c1.w)};
        float acc = 0.f;
#pragma unroll
        for (int j = 0; j < 16; ++j) { S[j] = dA * S[j] + xv * Bv[j]; acc += Cv[j] * S[j]; }
        acc += __shfl_xor(acc, 1); acc += __shfl_xor(acc, 2); acc += __shfl_xor(acc, 4);
        if (nq == 0) Y[row * ldy + h * 64 + p] = (bf16)f2bf(acc);
    }
}

#endif
#if !USE_NA_MFMA
__device__ __forceinline__ float dot64(const bf16* kp, const float (&q)[64]) {
    float s = 0.f;
#pragma unroll
    for (int c = 0; c < 8; ++c) { const u32x4 w = *(const u32x4*)(kp + 8 * c);
        s += q[8 * c] * bflo(w.x) + q[8 * c + 1] * bfhi(w.x) + q[8 * c + 2] * bflo(w.y) + q[8 * c + 3] * bfhi(w.y) + q[8 * c + 4] * bflo(w.z) + q[8 * c + 5] * bfhi(w.z) + q[8 * c + 6] * bflo(w.w) + q[8 * c + 7] * bfhi(w.w); }
    return s;
}
__device__ __forceinline__ void na_simple(Frame& F, int blk, int nblk) {
    bf16* proj = (bf16*)(F.ws + WS0_PROJ);
    const size_t total = (size_t)M * 16, stride = (size_t)nblk * NTHREADS;
    for (size_t i = (size_t)blk * NTHREADS + F.tid; i < total; i += stride) {
        const int row = (int)(i >> 4), h = (int)(i & 15), b = row / SEQ, t = row % SEQ, r = t >> 6, w = t & 63;
        int rs = r - 4; rs = rs < 0 ? 0 : (rs > 56 ? 56 : rs);
        int cs = w - 8; cs = cs < 0 ? 0 : (cs > 48 ? 48 : cs);
        float q[64];
        {
            const bf16* qp = proj + (size_t)row * LDP0 + P0_Q + h * 64;
#pragma unroll
            for (int c = 0; c < 8; ++c) { const u32x4 v = *(const u32x4*)(qp + 8 * c);
                q[8 * c] = bflo(v.x); q[8 * c + 1] = bfhi(v.x); q[8 * c + 2] = bflo(v.y); q[8 * c + 3] = bfhi(v.y); q[8 * c + 4] = bflo(v.z); q[8 * c + 5] = bfhi(v.z); q[8 * c + 6] = bflo(v.w); q[8 * c + 7] = bfhi(v.w); }
        }
        const float* rp = F.rpb + (size_t)h * 15 * 31;
        float mx = -1e30f;
        for (int ii = 0; ii < 8; ++ii) for (int jj = 0; jj < 16; ++jj) {
            const int kr = rs + ii, kc = cs + jj; const size_t krow = (size_t)b * SEQ + kr * 64 + kc;
            const float s = dot64(proj + krow * LDP0 + P0_K + h * 64, q) + rp[(kr - r + 7) * 31 + (kc - w + 15)];
            mx = fmaxf(mx, s);
        }
        float o[64]; float l = 0.f;
#pragma unroll
        for (int d = 0; d < 64; ++d) o[d] = 0.f;
        for (int ii = 0; ii < 8; ++ii) for (int jj = 0; jj < 16; ++jj) {
            const int kr = rs + ii, kc = cs + jj; const size_t krow = (size_t)b * SEQ + kr * 64 + kc;
            const float s = dot64(proj + krow * LDP0 + P0_K + h * 64, q) + rp[(kr - r + 7) * 31 + (kc - w + 15)];
            const float pr = __expf(s - mx); l += pr;
            const bf16* vp = proj + krow * LDP0 + P0_V + h * 64;
#pragma unroll
            for (int c = 0; c < 8; ++c) { const u32x4 v = *(const u32x4*)(vp + 8 * c);
                o[8 * c] += pr * bflo(v.x); o[8 * c + 1] += pr * bfhi(v.x); o[8 * c + 2] += pr * bflo(v.y); o[8 * c + 3] += pr * bfhi(v.y);
                o[8 * c + 4] += pr * bflo(v.z); o[8 * c + 5] += pr * bfhi(v.z); o[8 * c + 6] += pr * bflo(v.w); o[8 * c + 7] += pr * bfhi(v.w); }
        }
        const float inv = 1.f / l;
        bf16* op = proj + (size_t)row * LDP0 + P0_Q + h * 64;
#pragma unroll
        for (int c = 0; c < 8; ++c) { u32x4 v; v.x = pk2(o[8 * c] * inv, o[8 * c + 1] * inv); v.y = pk2(o[8 * c + 2] * inv, o[8 * c + 3] * inv); v.z = pk2(o[8 * c + 4] * inv, o[8 * c + 5] * inv); v.w = pk2(o[8 * c + 6] * inv, o[8 * c + 7] * inv);
            *(u32x4*)(op + 8 * c) = v; }
    }
}

#endif
__device__ __forceinline__ void gate_phase(Frame& F) {
    bf16* proj = (bf16*)(F.ws + WS0_PROJ);
    const bf16* yb = (const bf16*)(F.ws + WS0_XN);
    const bf16* xbc = (const bf16*)((unsigned char*)F.out + DO_XBC);
    const int gw = F.vcu * NWAVES + F.wave, NGW = F.G * NWAVES;
    for (int m = gw; m < M; m += NGW) {
        f32x4 v[4]; float ss = 0.f;
#pragma unroll
        for (int j = 0; j < 4; ++j) { const int c = 4 * F.lane + 256 * j;
            const u32x2 zf = *(const u32x2*)(proj + (size_t)m * LDP0 + P0_Z + c), yf = *(const u32x2*)(proj + (size_t)m * LDP0 + P0_XBC + c), ybv = *(const u32x2*)(yb + (size_t)m * DM + c), xs = *(const u32x2*)(xbc + (size_t)m * CONVCH + c);
            const float dsk = F.d_skip[c >> 6];
            f32x4 y; y.x = bflo(yf.x) + bflo(ybv.x) + dsk * bflo(xs.x); y.y = bfhi(yf.x) + bfhi(ybv.x) + dsk * bfhi(xs.x); y.z = bflo(yf.y) + bflo(ybv.y) + dsk * bflo(xs.y); y.w = bfhi(yf.y) + bfhi(ybv.y) + dsk * bfhi(xs.y);
            y.x *= silu_f(bflo(zf.x)); y.y *= silu_f(bfhi(zf.x)); y.z *= silu_f(bflo(zf.y)); y.w *= silu_f(bfhi(zf.y));
            v[j] = y; ss += (y.x * y.x + y.y * y.y) + (y.z * y.z + y.w * y.w); }
        const float rstd = rsqrtf(wave_sum(ss) * (1.f / DM) + EPS);
#pragma unroll
        for (int j = 0; j < 4; ++j) { const int c = 4 * F.lane + 256 * j; const f32x4 g = *(const f32x4*)(F.ssd_norm + c); const f32x4 o = v[j] * rstd * g;
            u32x2 w; w.x = pk2(o.x, o.y); w.y = pk2(o.z, o.w); *(u32x2*)(proj + (size_t)m * LDP0 + P0_Z + c) = w; }
    }
}

#if !USE_MLSTM_CHUNK
__device__ __forceinline__ void mlstm_simple_item(Frame& F, int item, int dir) {
    const int b = item >> 3, h = item & 7;
    const int v = F.tid & 255, kh = F.tid >> 8;
    const bf16* proj = (const bf16*)(F.ws + WS1_PROJ);
    const float* gates = (const float*)(F.ws + WS1_GATES);
    bf16* H = (bf16*)(F.ws + WS1_H);
    LAS float* qs = (LAS float*)F.lds;
    LAS float* red = qs + 256;
    float C[64], nn[64];
#pragma unroll
    for (int j = 0; j < 64; ++j) { C[j] = 0.f; nn[j] = 0.f; }
    for (int tt = 0; tt < SEQ; ++tt) {
        const int tok = dir ? SEQ - 1 - tt : tt; const size_t row = (size_t)b * SEQ + tok;
        if (F.tid < 256) { const int which = F.tid >> 7, kk = F.tid & 127; qs[F.tid] = bf2f(proj[row * LDP1 + (which ? P1_K : P1_Q) + h * 128 + kk]); }
        const float ig = gates[row * 32 + (dir * 2 + 0) * 8 + h], fg = gates[row * 32 + (dir * 2 + 1) * 8 + h];
        const float fs = sigmoid_f(fg), ie = __expf(ig);
        const float vv = bf2f(proj[row * LDP1 + P1_V + h * 256 + v]);
        __syncthreads();
        float num = 0.f, den = 0.f;
#pragma unroll
        for (int j = 0; j < 64; ++j) { const float kq = qs[kh * 64 + j], kk = qs[128 + kh * 64 + j];
            C[j] = fs * C[j] + (ie * kk) * vv; nn[j] = fs * nn[j] + ie * kk; num += kq * C[j]; den += kq * nn[j]; }
        red[kh * 256 + v] = num; if (v == 0) red[512 + kh] = den;
        __syncthreads();
        if (kh == 0) {
            const float nt = red[v] + red[256 + v], dn = red[512] + red[513];
            float hv = nt / fmaxf(fabsf(dn), 1.f);
            bf16* hp = H + row * 2048 + h * 256 + v;
            if (dir) hv += bf2f(*hp);
            *hp = (bf16)f2bf(hv);
        }
    }
}
#endif
typedef short s16x4 __attribute__((ext_vector_type(4)));
typedef float f32x16 __attribute__((ext_vector_type(16)));
typedef float f32x2 __attribute__((ext_vector_type(2)));
__device__ __forceinline__ s16x4 lds_tr(LAS const unsigned char* p) { return __builtin_bit_cast(s16x4, __builtin_amdgcn_ds_read_tr16_b64_v4i16((LAS s16x4*)p)); }
__device__ __forceinline__ bf16x8 tr8(LAS const unsigned char* p0, LAS const unsigned char* p1) { const s16x4 a = lds_tr(p0), b = lds_tr(p1); return (bf16x8){a.x, a.y, a.z, a.w, b.x, b.y, b.z, b.w}; }
#define MFMA32(a, b, c) __builtin_amdgcn_mfma_f32_32x32x16_bf16((a), (b), (c), 0, 0, 0)
namespace ck {
constexpr int SQ = 272, SV = 80;
constexpr int L_Q = 0, L_K = L_Q + 128 * SQ, L_P = L_K + 128 * SQ, L_V = L_P + 128 * SQ, L_VW = L_V + 128 * SV, L_CT = L_VW + 128 * SV, L_VEC = L_CT + 2 * 32 * SQ;
constexpr int VEC_BYTES = 3072;
constexpr int V_U2 = 0, V_Z2 = 512, V_ISC = 1024, V_DN = 1536, V_W = 2048, V_WROW = 2560, V_SCAL = 2816;
constexpr int L_DENP = L_VEC + 2 * VEC_BYTES, L_NROW = L_DENP + 1024, L_ZERO = L_NROW + 512, L_END = L_ZERO + 512;
constexpr float LOG2E = 1.4426950408889634f;
}
static_assert(ck::L_END <= LDS_BYTES - 64, "chunk-scan LDS map");
__device__ __forceinline__ float logsig_f(float x) { return fminf(x, 0.f) - log1pf(__expf(-fabsf(x))); }

__device__ __forceinline__ void mlstm_chunk_item(Frame& F, int item, int dir) {
    using namespace ck;
    const int b = item >> 6, h = (item >> 3) & 7, sl = item & 7;
    const int tid = F.tid, lane = F.lane, w = F.wave, l31 = lane & 31, hh = lane >> 5;
    const int blk = (lane >> 4) & 1, tq = (lane & 15) >> 2, tp = lane & 3;
    LAS unsigned char* lds = F.lds;
    const bf16* proj = (const bf16*)(F.ws + WS1_PROJ);
    const float* gates = (const float*)(F.ws + WS1_GATES);
    bf16* H = (bf16*)(F.ws + WS1_H);
    const size_t rowbase = (size_t)b * SEQ;
#define TOK(c, r) (dir ? (SEQ - 1 - ((c) * 128 + (r))) : ((c) * 128 + (r)))
    u32x4 rq[4], rk[4], rv; float gi0 = 0.f, gi1 = 0.f, gf0 = 0.f, gf1 = 0.f;
#define CK_LOAD(c) do { \
        _Pragma("unroll") for (int j = 0; j < 4; ++j) { const int pid = tid + 512 * j, r = pid >> 4, ch = pid & 15; const bf16* rp = proj + (rowbase + TOK(c, r)) * LDP1 + h * 128 + 8 * ch; \
            rq[j] = *(const u32x4*)(rp + P1_Q); rk[j] = *(const u32x4*)(rp + P1_K); } \
        { const int r = tid >> 2, ch = tid & 3; rv = *(const u32x4*)(proj + (rowbase + TOK(c, r)) * LDP1 + P1_V + h * 256 + sl * 32 + 8 * ch); } \
        if (w == 7) { const size_t g0 = (rowbase + TOK(c, 2 * lane)) * 32, g1 = (rowbase + TOK(c, 2 * lane + 1)) * 32; \
            gi0 = gates[g0 + (dir * 2) * 8 + h]; gf0 = gates[g0 + (dir * 2 + 1) * 8 + h]; gi1 = gates[g1 + (dir * 2) * 8 + h]; gf1 = gates[g1 + (dir * 2 + 1) * 8 + h]; } } while (0)
    float m_prev = 0.f;
#define CK_GATES(nb) do { \
        LAS unsigned char* vb = lds + L_VEC + (nb) * VEC_BYTES; \
        const float lf0 = logsig_f(gf0), lf1 = logsig_f(gf1), ps = lf0 + lf1; float sc = ps; \
        _Pragma("unroll") for (int o = 1; o < 64; o <<= 1) { const float t_ = __shfl_up(sc, o); if (lane >= o) sc += t_; } \
        const float b0 = (sc - ps) + lf0, b1 = b0 + lf1, z0 = gi0 - b0, z1 = gi1 - b1, pm = fmaxf(z0, z1); float sm = pm; \
        _Pragma("unroll") for (int o = 1; o < 64; o <<= 1) { const float t_ = __shfl_up(sm, o); if (lane >= o) sm = fmaxf(sm, t_); } \
        float exm = __shfl_up(sm, 1); if (lane == 0) exm = -3.0e38f; \
        const float pmz0 = fmaxf(exm, z0), pmz1 = fmaxf(exm, pm), gtot = __shfl(sc, 63), zmax = __shfl(sm, 63); \
        const float u0 = -fmaxf(m_prev, pmz0), u1 = -fmaxf(m_prev, pmz1); \
        *(LAS f32x2*)(vb + V_U2 + 8 * lane) = (f32x2){u0 * LOG2E, u1 * LOG2E}; \
        *(LAS f32x2*)(vb + V_Z2 + 8 * lane) = (f32x2){z0 * LOG2E, z1 * LOG2E}; \
        *(LAS f32x2*)(vb + V_ISC + 8 * lane) = (f32x2){__expf(m_prev + u0), __expf(m_prev + u1)}; \
        *(LAS f32x2*)(vb + V_DN + 8 * lane) = (f32x2){__expf(u0 - b0), __expf(u1 - b1)}; \
        const float w0 = __expf(z0 - zmax), w1 = __expf(z1 - zmax); \
        *(LAS f32x2*)(vb + V_W + 8 * lane) = (f32x2){w0, w1}; \
        *(LAS unsigned*)(vb + V_WROW + 4 * lane) = pk2(w0, w1); \
        const float Mx = fmaxf(m_prev, zmax); \
        if (lane == 0) *(LAS f32x2*)(vb + V_SCAL) = (f32x2){__expf(m_prev - Mx), __expf(zmax - Mx)}; \
        m_prev = gtot + Mx; } while (0)
#define CK_WRITE(nb) do { \
        _Pragma("unroll") for (int j = 0; j < 4; ++j) { const int pid = tid + 512 * j, r = pid >> 4, ch = pid & 15; \
            *(LAS u32x4*)(lds + L_Q + r * SQ + ch * 16) = rq[j]; *(LAS u32x4*)(lds + L_K + r * SQ + ch * 16) = rk[j]; } \
        { const int r = tid >> 2, ch = tid & 3; *(LAS u32x4*)(lds + L_V + r * SV + ch * 16) = rv; \
          const float wv = *(LAS float*)(lds + L_VEC + (nb) * VEC_BYTES + V_W + 4 * r); u32x4 o; \
          o.x = pk2(bflo(rv.x) * wv, bfhi(rv.x) * wv); o.y = pk2(bflo(rv.y) * wv, bfhi(rv.y) * wv); o.z = pk2(bflo(rv.z) * wv, bfhi(rv.z) * wv); o.w = pk2(bflo(rv.w) * wv, bfhi(rv.w) * wv); \
          *(LAS u32x4*)(lds + L_VW + r * SV + ch * 16) = o; } } while (0)

    __syncthreads();
    for (int i = tid; i < (2 * 32 * SQ) / 4; i += NTHREADS) ((LAS unsigned*)(lds + L_CT))[i] = 0u;
    for (int i = tid; i < (512 + 512) / 4; i += NTHREADS) ((LAS unsigned*)(lds + L_NROW))[i] = 0u;
    f32x16 Cst; float nst = 0.f;
#pragma unroll
    for (int i = 0; i < 16; ++i) Cst[i] = 0.f;
    CK_LOAD(0);
    if (w == 7) CK_GATES(0);
    __syncthreads();
    CK_WRITE(0);
    __syncthreads();

    for (int c = 0; c < SEQ / 128; ++c) {
        const int cur = c & 1, nxt = cur ^ 1;
        const bool more = (c + 1 < SEQ / 128);
        if (more) CK_LOAD(c + 1);
        LAS unsigned char* vc = lds + L_VEC + cur * VEC_BYTES;
        {
            const int tb = w & 3, sbp = w >> 2, t = 32 * tb + l31;
            const float ut = *(LAS float*)(vc + V_U2 + 4 * t);
            float rs = 0.f;
            if (2 * sbp <= tb) {
                bf16x8 qf[8];
#pragma unroll
                for (int ks = 0; ks < 8; ++ks) qf[ks] = *(LAS bf16x8*)(lds + L_Q + t * SQ + (16 * ks + 8 * hh) * 2);
#pragma unroll 1
                for (int sbi = 0; sbi < 2; ++sbi) {
                    const int sb = 2 * sbp + sbi;
                    if (sb <= tb) {
                        f32x16 acc;
#pragma unroll
                        for (int i = 0; i < 16; ++i) acc[i] = 0.f;
#pragma unroll
                        for (int ks = 0; ks < 8; ++ks) { const bf16x8 kf = *(LAS bf16x8*)(lds + L_K + (32 * sb + l31) * SQ + (16 * ks + 8 * hh) * 2); acc = MFMA32(kf, qf[ks], acc); }
#pragma unroll
                        for (int g = 0; g < 4; ++g) {
                            const int s0 = 32 * sb + 8 * g + 4 * hh;
                            const f32x4 zz = *(LAS f32x4*)(vc + V_Z2 + 4 * s0);
                            float pv[4];
#pragma unroll
                            for (int e = 0; e < 4; ++e) { float v = acc[4 * g + e] * __builtin_amdgcn_exp2f(ut + zz[e]); v = (s0 + e > t) ? 0.f : v; rs += v; pv[e] = v; }
                            u32x2 o; o.x = pk2(pv[0], pv[1]); o.y = pk2(pv[2], pv[3]);
                            *(LAS u32x2*)(lds + L_P + t * SQ + s0 * 2) = o;
                        }
                    }
                }
            }
            rs += __shfl_xor(rs, 32);
            if (hh == 0) *(LAS float*)(lds + L_DENP + (sbp * 128 + t) * 4) = rs;
        }
        __syncthreads();
        if (w < 4) {
            const int tb = w, t = 32 * tb + l31;
            bf16* hp = H + (rowbase + TOK(c, t)) * 2048 + h * 256 + sl * 32 + 4 * hh;
            u32x2 hold[4];
            if (dir) {
#pragma unroll
                for (int g = 0; g < 4; ++g) hold[g] = *(const u32x2*)(hp + 8 * g);
            }
            f32x16 ai, ae, an;
#pragma unroll
            for (int i = 0; i < 16; ++i) { ai[i] = 0.f; ae[i] = 0.f; an[i] = 0.f; }
            const int nks = 2 * (tb + 1);
            for (int ks = 0; ks < nks; ++ks) {
                LAS const unsigned char* va = lds + L_V + (16 * ks + 8 * hh + tq) * SV + (16 * blk + 4 * tp) * 2;
                const bf16x8 a = tr8(va, va + 4 * SV);
                const bf16x8 bb = *(LAS bf16x8*)(lds + L_P + t * SQ + (16 * ks + 8 * hh) * 2);
                ai = MFMA32(a, bb, ai);
            }
            LAS const unsigned char* nrp = (l31 == 0) ? (lds + L_NROW + cur * 256) : (lds + L_ZERO);
#pragma unroll
            for (int ks = 0; ks < 8; ++ks) {
                const bf16x8 qf = *(LAS bf16x8*)(lds + L_Q + t * SQ + (16 * ks + 8 * hh) * 2);
                const bf16x8 a = *(LAS bf16x8*)(lds + L_CT + cur * 32 * SQ + l31 * SQ + (16 * ks + 8 * hh) * 2);
                ae = MFMA32(a, qf, ae);
                const bf16x8 nf = *(LAS bf16x8*)(nrp + (16 * ks + 8 * hh) * 2);
                an = MFMA32(nf, qf, an);
            }
            const float isc = *(LAS float*)(vc + V_ISC + 4 * t), dnt = *(LAS float*)(vc + V_DN + 4 * t);
            const float qn = __shfl(an[0], l31);
            const float den = *(LAS float*)(lds + L_DENP + t * 4) + *(LAS float*)(lds + L_DENP + (128 + t) * 4) + isc * qn;
            const float inv = 1.f / fmaxf(fabsf(den), dnt);
#pragma unroll
            for (int g = 0; g < 4; ++g) {
                float hv[4];
#pragma unroll
                for (int e = 0; e < 4; ++e) hv[e] = (ai[4 * g + e] + isc * ae[4 * g + e]) * inv;
                if (dir) { hv[0] += bflo(hold[g].x); hv[1] += bfhi(hold[g].x); hv[2] += bflo(hold[g].y); hv[3] += bfhi(hold[g].y); }
                u32x2 o; o.x = pk2(hv[0], hv[1]); o.y = pk2(hv[2], hv[3]);
                *(u32x2*)(hp + 8 * g) = o;
            }
        } else {
            const int kb = w - 4;
            f32x16 dC, dnn;
#pragma unroll
            for (int i = 0; i < 16; ++i) { dC[i] = 0.f; dnn[i] = 0.f; }
            LAS const unsigned char* wrp = (l31 == 0) ? (vc + V_WROW) : (lds + L_ZERO);
#pragma unroll
            for (int ks = 0; ks < 8; ++ks) {
                LAS const unsigned char* ka = lds + L_K + (16 * ks + 8 * hh + tq) * SQ + (32 * kb + 16 * blk + 4 * tp) * 2;
                const bf16x8 kf = tr8(ka, ka + 4 * SQ);
                LAS const unsigned char* va = lds + L_VW + (16 * ks + 8 * hh + tq) * SV + (16 * blk + 4 * tp) * 2;
                const bf16x8 vf = tr8(va, va + 4 * SV);
                dC = MFMA32(kf, vf, dC);
                const bf16x8 wf = *(LAS bf16x8*)(wrp + (16 * ks + 8 * hh) * 2);
                dnn = MFMA32(wf, kf, dnn);
            }
            const f32x2 ss = *(LAS f32x2*)(vc + V_SCAL);
#pragma unroll
            for (int i = 0; i < 16; ++i) Cst[i] = ss.x * Cst[i] + ss.y * dC[i];
#pragma unroll
            for (int g = 0; g < 4; ++g) { u32x2 o; o.x = pk2(Cst[4 * g], Cst[4 * g + 1]); o.y = pk2(Cst[4 * g + 2], Cst[4 * g + 3]);
                *(LAS u32x2*)(lds + L_CT + nxt * 32 * SQ + l31 * SQ + (32 * kb + 8 * g + 4 * hh) * 2) = o; }
            nst = ss.x * nst + ss.y * dnn[0];
            if (hh == 0) *(LAS bf16*)(lds + L_NROW + nxt * 256 + (32 * kb + l31) * 2) = (bf16)f2bf(nst);
            if (w == 7 && more) CK_GATES(nxt);
        }
        __syncthreads();
        if (more) CK_WRITE(nxt);
        __syncthreads();
    }
#undef TOK
#undef CK_LOAD
#undef CK_GATES
#undef CK_WRITE
}

__device__ __forceinline__ void ssd_chunk_item(Frame& F, int item) {
    using namespace ck;
    const int dir = item >> 7, b = (item >> 5) & 3, h = (item >> 1) & 15, ph = item & 1, gq = h >> 3;
    const int tid = F.tid, lane = F.lane, w = F.wave, l31 = lane & 31, hh = lane >> 5;
    const int blk = (lane >> 4) & 1, tq = (lane & 15) >> 2, tp = lane & 3;
    LAS unsigned char* lds = F.lds;
    const bf16* xbc = (const bf16*)((unsigned char*)F.out + DO_XBC);
    const float* dtp = (const float*)(F.ws + WS0_DT);
    bf16* Y; int ldy;
    if (dir == 0) { Y = (bf16*)(F.ws + WS0_PROJ) + P0_XBC; ldy = LDP0; } else { Y = (bf16*)(F.ws + WS0_XN); ldy = DM; }
    const float a_h = -__expf(F.a_log[dir * 16 + h]);
    const size_t rowbase = (size_t)b * SEQ;
#define TOK(c, r) (dir ? (SEQ - 1 - ((c) * 128 + (r))) : ((c) * 128 + (r)))
    u32x4 rq[4], rk[4], rv; float d0 = 0.f, d1 = 0.f;
#define SK_LOAD(c) do { \
        _Pragma("unroll") for (int j = 0; j < 4; ++j) { const int pid = tid + 512 * j, r = pid >> 4, ch = pid & 15; const bf16* rp = xbc + (rowbase + TOK(c, r)) * CONVCH + gq * 128 + 8 * ch; \
            rq[j] = *(const u32x4*)(rp + 1280); rk[j] = *(const u32x4*)(rp + 1024); } \
        { const int r = tid >> 2, ch = tid & 3; rv = *(const u32x4*)(xbc + (rowbase + TOK(c, r)) * CONVCH + h * 64 + ph * 32 + 8 * ch); } \
        if (w == 7) { d0 = dtp[(rowbase + TOK(c, 2 * lane)) * 32 + dir * 16 + h]; d1 = dtp[(rowbase + TOK(c, 2 * lane + 1)) * 32 + dir * 16 + h]; } } while (0)
#define SK_GATES(nb) do { \
        LAS unsigned char* vb = lds + L_VEC + (nb) * VEC_BYTES; \
        const float a0 = d0 * a_h, a1 = d1 * a_h, ps = a0 + a1; float sc = ps; \
        _Pragma("unroll") for (int o = 1; o < 64; o <<= 1) { const float t_ = __shfl_up(sc, o); if (lane >= o) sc += t_; } \
        const float cs0 = (sc - ps) + a0, cs1 = cs0 + a1, tot = __shfl(sc, 63); \
        *(LAS f32x2*)(vb + V_U2 + 8 * lane) = (f32x2){cs0 * LOG2E, cs1 * LOG2E}; \
        *(LAS f32x2*)(vb + V_Z2 + 8 * lane) = (f32x2){-cs0 * LOG2E, -cs1 * LOG2E}; \
        *(LAS f32x2*)(vb + V_ISC + 8 * lane) = (f32x2){__expf(cs0), __expf(cs1)}; \
        *(LAS f32x2*)(vb + V_DN + 8 * lane) = (f32x2){d0, d1}; \
        *(LAS f32x2*)(vb + V_W + 8 * lane) = (f32x2){__expf(tot - cs0), __expf(tot - cs1)}; \
        if (lane == 0) *(LAS f32x2*)(vb + V_SCAL) = (f32x2){__expf(tot), 1.f}; } while (0)
#define SK_WRITE(nb) do { \
        _Pragma("unroll") for (int j = 0; j < 4; ++j) { const int pid = tid + 512 * j, r = pid >> 4, ch = pid & 15; \
            *(LAS u32x4*)(lds + L_Q + r * SQ + ch * 16) = rq[j]; *(LAS u32x4*)(lds + L_K + r * SQ + ch * 16) = rk[j]; } \
        { const int r = tid >> 2, ch = tid & 3; \
          const float dv = *(LAS float*)(lds + L_VEC + (nb) * VEC_BYTES + V_DN + 4 * r), wv = dv * *(LAS float*)(lds + L_VEC + (nb) * VEC_BYTES + V_W + 4 * r); u32x4 o; \
          o.x = pk2(bflo(rv.x) * dv, bfhi(rv.x) * dv); o.y = pk2(bflo(rv.y) * dv, bfhi(rv.y) * dv); o.z = pk2(bflo(rv.z) * dv, bfhi(rv.z) * dv); o.w = pk2(bflo(rv.w) * dv, bfhi(rv.w) * dv); \
          *(LAS u32x4*)(lds + L_V + r * SV + ch * 16) = o; \
          o.x = pk2(bflo(rv.x) * wv, bfhi(rv.x) * wv); o.y = pk2(bflo(rv.y) * wv, bfhi(rv.y) * wv); o.z = pk2(bflo(rv.z) * wv, bfhi(rv.z) * wv); o.w = pk2(bflo(rv.w) * wv, bfhi(rv.w) * wv); \
          *(LAS u32x4*)(lds + L_VW + r * SV + ch * 16) = o; } } while (0)

    __syncthreads();
    for (int i = tid; i < (2 * 32 * SQ) / 4; i += NTHREADS) ((LAS unsigned*)(lds + L_CT))[i] = 0u;
    f32x16 Sst;
#pragma unroll
    for (int i = 0; i < 16; ++i) Sst[i] = 0.f;
    SK_LOAD(0);
    if (w == 7) SK_GATES(0);
    __syncthreads();
    SK_WRITE(0);
    __syncthreads();

    for (int c = 0; c < SEQ / 128; ++c) {
        const int cur = c & 1, nxt = cur ^ 1;
        const bool more = (c + 1 < SEQ / 128);
        if (more) SK_LOAD(c + 1);
        LAS unsigned char* vc = lds + L_VEC + cur * VEC_BYTES;
        {
            const int tb = w & 3, sbp = w >> 2, t = 32 * tb + l31;
            const float ut = *(LAS float*)(vc + V_U2 + 4 * t);
            if (2 * sbp <= tb) {
                bf16x8 qf[8];
#pragma unroll
                for (int ks = 0; ks < 8; ++ks) qf[ks] = *(LAS bf16x8*)(lds + L_Q + t * SQ + (16 * ks + 8 * hh) * 2);
#pragma unroll 1
                for (int sbi = 0; sbi < 2; ++sbi) {
                    const int sb = 2 * sbp + sbi;
                    if (sb <= tb) {
                        f32x16 acc;
#pragma unroll
                        for (int i = 0; i < 16; ++i) acc[i] = 0.f;
#pragma unroll
                        for (int ks = 0; ks < 8; ++ks) { const bf16x8 kf = *(LAS bf16x8*)(lds + L_K + (32 * sb + l31) * SQ + (16 * ks + 8 * hh) * 2); acc = MFMA32(kf, qf[ks], acc); }
#pragma unroll
                        for (int g = 0; g < 4; ++g) {
                            const int s0 = 32 * sb + 8 * g + 4 * hh;
                            const f32x4 zz = *(LAS f32x4*)(vc + V_Z2 + 4 * s0);
                            float pv[4];
#pragma unroll
                            for (int e = 0; e < 4; ++e) { float v = acc[4 * g + e] * __builtin_amdgcn_exp2f(ut + zz[e]); pv[e] = (s0 + e > t) ? 0.f : v; }
                            u32x2 o; o.x = pk2(pv[0], pv[1]); o.y = pk2(pv[2], pv[3]);
                            *(LAS u32x2*)(lds + L_P + t * SQ + s0 * 2) = o;
                        }
                    }
                }
            }
        }
        __syncthreads();
        if (w < 4) {
            const int tb = w, t = 32 * tb + l31;
            bf16* yp = Y + (rowbase + TOK(c, t)) * ldy + h * 64 + ph * 32 + 4 * hh;
            f32x16 ai, ae;
#pragma unroll
            for (int i = 0; i < 16; ++i) { ai[i] = 0.f; ae[i] = 0.f; }
            const int nks = 2 * (tb + 1);
            for (int ks = 0; ks < nks; ++ks) {
                LAS const unsigned char* va = lds + L_V + (16 * ks + 8 * hh + tq) * SV + (16 * blk + 4 * tp) * 2;
                const bf16x8 a = tr8(va, va + 4 * SV);
                const bf16x8 bb = *(LAS bf16x8*)(lds + L_P + t * SQ + (16 * ks + 8 * hh) * 2);
                ai = MFMA32(a, bb, ai);
            }
#pragma unroll
            for (int ks = 0; ks < 8; ++ks) {
                const bf16x8 qf = *(LAS bf16x8*)(lds + L_Q + t * SQ + (16 * ks + 8 * hh) * 2);
                const bf16x8 a = *(LAS bf16x8*)(lds + L_CT + cur * 32 * SQ + l31 * SQ + (16 * ks + 8 * hh) * 2);
                ae = MFMA32(a, qf, ae);
            }
            const float isc = *(LAS float*)(vc + V_ISC + 4 * t);
#pragma unroll
            for (int g = 0; g < 4; ++g) {
                u32x2 o; o.x = pk2(ai[4 * g] + isc * ae[4 * g], ai[4 * g + 1] + isc * ae[4 * g + 1]); o.y = pk2(ai[4 * g + 2] + isc * ae[4 * g + 2], ai[4 * g + 3] + isc * ae[4 * g + 3]);
                *(u32x2*)(yp + 8 * g) = o;
            }
        } else {
            const int kb = w - 4;
            f32x16 dS;
#pragma unroll
            for (int i = 0; i < 16; ++i) dS[i] = 0.f;
#pragma unroll
            for (int ks = 0; ks < 8; ++ks) {
                LAS const unsigned char* ka = lds + L_K + (16 * ks + 8 * hh + tq) * SQ + (32 * kb + 16 * blk + 4 * tp) * 2;
                const bf16x8 kf = tr8(ka, ka + 4 * SQ);
                LAS const unsigned char* va = lds + L_VW + (16 * ks + 8 * hh + tq) * SV + (16 * blk + 4 * tp) * 2;
                const bf16x8 vf = tr8(va, va + 4 * SV);
                dS = MFMA32(kf, vf, dS);
            }
            const f32x2 ss = *(LAS f32x2*)(vc + V_SCAL);
#pragma unroll
            for (int i = 0; i < 16; ++i) Sst[i] = ss.x * Sst[i] + dS[i];
#pragma unroll
            for (int g = 0; g < 4; ++g) { u32x2 o; o.x = pk2(Sst[4 * g], Sst[4 * g + 1]); o.y = pk2(Sst[4 * g + 2], Sst[4 * g + 3]);
                *(LAS u32x2*)(lds + L_CT + nxt * 32 * SQ + l31 * SQ + (32 * kb + 8 * g + 4 * hh) * 2) = o; }
            if (w == 7 && more) SK_GATES(nxt);
        }
        __syncthreads();
        if (more) SK_WRITE(nxt);
        __syncthreads();
    }
#undef TOK
#undef SK_LOAD
#undef SK_GATES
#undef SK_WRITE
}

#define MFMA16(a, b, c) __builtin_amdgcn_mfma_f32_16x16x32_bf16((a), (b), (c), 0, 0, 0)
namespace na {
constexpr int SVN = 144, HS = 512 * SVN, L_RPB = 2 * HS, L_END = L_RPB + 2 * 465 * 4;
}
static_assert(na::L_END <= LDS_BYTES - 64, "NA LDS map");
__device__ __forceinline__ void na_mfma_item(Frame& F, int item) {
    using namespace na;
    const int b = item >> 6, hp = (item >> 3) & 7, r0 = (item & 7) * 8;
    const int tid = F.tid, lane = F.lane, w = F.wave, fr = lane & 15, fg = lane >> 4, tq = fr >> 2, tp = fr & 3;
    const int hsel = w >> 2, qb = w & 3, h = 2 * hp + hsel;
    LAS unsigned char* lds = F.lds;
    bf16* proj = (bf16*)(F.ws + WS0_PROJ);
    const size_t rowbase = (size_t)b * SEQ;
    __syncthreads();
    for (int i = tid; i < 2 * 465; i += NTHREADS) *(LAS float*)(lds + L_RPB + 4 * i) = F.rpb[(size_t)(2 * hp) * 465 + i];
    int rs = r0 - 4; rs = rs < 0 ? 0 : (rs > 56 ? 56 : rs);
#pragma unroll 4
    for (int j = 0; j < 16; ++j) { const int pid = tid + 512 * j, ch = pid & 7, hs = (pid >> 3) & 1, c = (pid >> 4) & 63, i = pid >> 10, kr = rs + i;
        const u32x4 v = *(const u32x4*)(proj + (rowbase + kr * 64 + c) * LDP0 + P0_V + (2 * hp + hs) * 64 + 8 * ch);
        *(LAS u32x4*)(lds + hs * HS + ((kr & 7) * 64 + c) * SVN + ch * 16) = v; }
    __syncthreads();
    const int kb0 = qb < 1 ? 0 : (qb > 2 ? 1 : qb - 1);
    const int wq = 16 * qb + fr;
    int cs = wq - 8; cs = cs < 0 ? 0 : (cs > 48 ? 48 : cs);
    const LAS float* rp = (const LAS float*)(lds + L_RPB + hsel * 465 * 4);
    for (int r = r0; r < r0 + 8; ++r) {
        int rsn = r + 1 - 4; rsn = rsn < 0 ? 0 : (rsn > 56 ? 56 : rsn);
        const bool slide = (r + 1 < r0 + 8) && (rsn != rs);
        u32x4 nv[2];
        if (slide) {
#pragma unroll
            for (int j = 0; j < 2; ++j) { const int pid = tid + 512 * j, ch = pid & 7, hs = (pid >> 3) & 1, c = (pid >> 4) & 63;
                nv[j] = *(const u32x4*)(proj + (rowbase + (rsn + 7) * 64 + c) * LDP0 + P0_V + (2 * hp + hs) * 64 + 8 * ch); }
        }
        bf16* qp = proj + (rowbase + r * 64 + wq) * LDP0 + P0_Q + h * 64;
        const bf16x8 q0 = *(const bf16x8*)(qp + 8 * fg), q1 = *(const bf16x8*)(qp + 32 + 8 * fg);
        f32x4 S[24];
#pragma unroll
        for (int i = 0; i < 8; ++i)
#pragma unroll
            for (int kb = 0; kb < 3; ++kb) {
                const bf16* kp = proj + (rowbase + (rs + i) * 64 + 16 * (kb0 + kb) + fr) * LDP0 + P0_K + h * 64 + 8 * fg;
                const bf16x8 k0 = *(const bf16x8*)kp, k1 = *(const bf16x8*)(kp + 32);
                f32x4 a = (f32x4){0.f, 0.f, 0.f, 0.f};
                a = MFMA16(k0, q0, a); a = MFMA16(k1, q1, a);
                S[i * 3 + kb] = a;
            }
        float mx = -3.0e38f;
#pragma unroll
        for (int i = 0; i < 8; ++i)
#pragma unroll
            for (int kb = 0; kb < 3; ++kb)
#pragma unroll
                for (int e = 0; e < 4; ++e) {
                    const int kc = 16 * (kb0 + kb) + 4 * fg + e;
                    const bool valid = (kc >= cs) && (kc < cs + 16);
                    const int bi = (rs + i - r + 7) * 31 + (valid ? (kc - wq + 15) : 0);
                    const float s = valid ? S[i * 3 + kb][e] + rp[bi] : -3.0e38f;
                    S[i * 3 + kb][e] = s; mx = fmaxf(mx, s);
                }
        mx = fmaxf(mx, __shfl_xor(mx, 16)); mx = fmaxf(mx, __shfl_xor(mx, 32));
        float l = 0.f;
#pragma unroll
        for (int t = 0; t < 24; ++t)
#pragma unroll
            for (int e = 0; e < 4; ++e) { const float p = __expf(S[t][e] - mx); S[t][e] = p; l += p; }
        l += __shfl_xor(l, 16); l += __shfl_xor(l, 32);
        f32x4 o[4];
#pragma unroll
        for (int db = 0; db < 4; ++db) o[db] = (f32x4){0.f, 0.f, 0.f, 0.f};
#pragma unroll
        for (int u = 0; u < 12; ++u) {
            const int t0 = 2 * u, t1 = 2 * u + 1, i0 = t0 / 3, k0b = t0 % 3, i1 = t1 / 3, k1b = t1 % 3;
            bf16x8 pf; { const unsigned a0 = pk2(S[t0][0], S[t0][1]), a1 = pk2(S[t0][2], S[t0][3]), a2 = pk2(S[t1][0], S[t1][1]), a3 = pk2(S[t1][2], S[t1][3]);
                const u32x4 pw = (u32x4){a0, a1, a2, a3}; pf = __builtin_bit_cast(bf16x8, pw); }
            LAS const unsigned char* v0 = lds + hsel * HS + ((((rs + i0) & 7) * 64) + 16 * (kb0 + k0b) + 4 * fg + tq) * SVN + (4 * tp) * 2;
            LAS const unsigned char* v1 = lds + hsel * HS + ((((rs + i1) & 7) * 64) + 16 * (kb0 + k1b) + 4 * fg + tq) * SVN + (4 * tp) * 2;
#pragma unroll
            for (int db = 0; db < 4; ++db) { const bf16x8 vf = tr8(v0 + db * 32, v1 + db * 32); o[db] = MFMA16(vf, pf, o[db]); }
        }
        const float inv = 1.f / l;
#pragma unroll
        for (int db = 0; db < 4; ++db) { u32x2 ov; ov.x = pk2(o[db][0] * inv, o[db][1] * inv); ov.y = pk2(o[db][2] * inv, o[db][3] * inv);
            *(u32x2*)(qp + 16 * db + 4 * fg) = ov; }
        __syncthreads();
        if (slide) {
#pragma unroll
            for (int j = 0; j < 2; ++j) { const int pid = tid + 512 * j, ch = pid & 7, hs = (pid >> 3) & 1, c = (pid >> 4) & 63;
                *(LAS u32x4*)(lds + hs * HS + ((((rsn + 7) & 7) * 64) + c) * SVN + ch * 16) = nv[j]; }
        }
        __syncthreads();
        rs = rsn;
    }
}

__device__ __forceinline__ void headstat_phase(Frame& F) {
    const bf16* H = (const bf16*)(F.ws + WS1_H); float* RS = (float*)(F.ws + WS1_RS);
    const int gw = F.vcu * NWAVES + F.wave, NGW = F.G * NWAVES;
    for (int m = gw; m < M; m += NGW) {
        float ss = 0.f;
#pragma unroll
        for (int c = 0; c < 4; ++c) { const u32x4 w = *(const u32x4*)(H + (size_t)m * 2048 + F.lane * 32 + 8 * c);
            const float a0 = bflo(w.x), a1 = bfhi(w.x), a2 = bflo(w.y), a3 = bfhi(w.y), a4 = bflo(w.z), a5 = bfhi(w.z), a6 = bflo(w.w), a7 = bfhi(w.w);
            ss += (a0 * a0 + a1 * a1) + (a2 * a2 + a3 * a3) + (a4 * a4 + a5 * a5) + (a6 * a6 + a7 * a7); }
        ss += __shfl_xor(ss, 1); ss += __shfl_xor(ss, 2); ss += __shfl_xor(ss, 4);
        if ((F.lane & 7) == 0) RS[(size_t)m * 8 + (F.lane >> 3)] = rsqrtf(ss * (1.f / 256.f) + EPS);
    }
}

__global__ void __launch_bounds__(NTHREADS, 2) mega_fwd(Args args) {
    extern __shared__ __attribute__((aligned(16))) unsigned char lds_raw[];
    Frame F;
    F.lds = (LAS unsigned char*)lds_raw;
    F.tid = threadIdx.x; F.lane = F.tid & 63; F.wave = __builtin_amdgcn_readfirstlane(F.tid >> 6);
    F.G = gridDim.x; { const int bx = blockIdx.x; F.vcu = (F.G % 8 == 0) ? (bx % 8) * (F.G / 8) + bx / 8 : bx; }
    F.x = args.in[0]; F.c = args.in[1]; F.ada_w = args.in[2]; F.ada_b = args.in[3]; F.norm_g = args.in[4]; F.mlp_w1 = args.in[5]; F.mlp_w2 = args.in[6];
    F.ab_w_in = args.in[7]; F.conv_w = args.in[8]; F.conv_b = args.in[9]; F.dt_bias = args.in[10]; F.a_log = args.in[11]; F.d_skip = args.in[12]; F.ssd_norm = args.in[13];
    F.rpb = args.in[14]; F.ab_w_out = args.in[15]; F.ml_w_in = args.in[16]; F.gate_b = args.in[17]; F.head_norm = args.in[18]; F.ml_w_out = args.in[19];
    F.out = args.out; F.ws = args.ws;
    unsigned char* ws = args.ws;
    float* mod = (float*)(ws + WS_MOD);
    volatile LAS unsigned* MISC = (volatile LAS unsigned*)(F.lds + LDS_BYTES - 64);
    if (F.tid < 16) MISC[F.tid] = 0u;
    __syncthreads();
    XcdBarrier bar; bar.bar = (unsigned*)(ws + WS_CTL) + 4096; bar.x = 0; bar.st = nullptr;
    if (MK_ONE_LAUNCH) bar = xcd_barrier_post((unsigned*)(ws + WS_CTL) + 4096, MISC + 8);
    const int lo = args.ph_lo, hi = args.ph_hi;
#define IN(k) (lo <= (k) && (k) < hi && phase_begin(F))
#define SEAM(k) do { if (lo <= (k) && (k) + 1 < hi) xcd_barrier(bar); } while (0)

    if (IN(0)) {
        const TrJob jobs[7] = {
            {F.ab_w_in, 1024, ABIN, 0, 1024, (bf16*)(ws + W0_IN)},
            {F.ab_w_in, 1024, ABIN, 2592, 3072, (bf16*)(ws + W0_IN) + (size_t)1024 * 1024},
            {F.ab_w_in, 1024, ABIN, 1024, 1536, (bf16*)(ws + W0_IN) + (size_t)4096 * 1024},
            {F.ab_w_in, 1024, ABIN, 2560, 32, (bf16*)(ws + W0_DT)},
            {F.ab_w_out, 2048, 1024, 0, 1024, (bf16*)(ws + W0_OUT)},
            {F.mlp_w1, 1024, FF, 0, FF, (bf16*)(ws + W0_W1)},
            {F.mlp_w2, FF, 1024, 0, 1024, (bf16*)(ws + W0_W2)}};
        transpose_jobs(F, jobs);
        __syncthreads();
        mod_phase(F);
    }
    SEAM(0);
    if (IN(1)) rowpass<false, true>(F, F.x, nullptr, nullptr, nullptr, nullptr, F.norm_g + 0, mod + 0, mod + 1024, (bf16*)(ws + WS0_XN));
    SEAM(1);
    if (IN(2)) {
        EpiBf16 E{(bf16*)(ws + WS0_PROJ), LDP0, P0_Q, P0_K, 0.125f};
        gemm_big(F, (const bf16*)(ws + WS0_XN), DM, (const bf16*)(ws + W0_IN), M, LDP0, DM, E);
        EpiDt Ed{(float*)(ws + WS0_DT), F.dt_bias};
        gemm_simple(F, (const bf16*)(ws + WS0_XN), DM, (const bf16*)(ws + W0_DT), M, 32, DM, Ed);
    }
    SEAM(2);
    if (IN(3)) conv_phase(F);
    SEAM(3);
    if (IN(4)) {
#if USE_SSD_CHUNK
        for (int it = blockIdx.x; it < 256; it += F.G) ssd_chunk_item(F, it);
#if USE_NA_MFMA
        for (int it = blockIdx.x; it < 256; it += F.G) na_mfma_item(F, it);
#else
        na_simple(F, blockIdx.x, F.G);
#endif
#else
        if ((int)blockIdx.x < 128) ssd_simple_item(F, blockIdx.x);
        else na_simple(F, blockIdx.x - 128, F.G - 128);
#endif
    }
    SEAM(4);
    if (IN(5)) gate_phase(F);
    SEAM(5);
    if (IN(6)) { EpiBf16 E{(bf16*)(ws + WS0_XN), DM, 0, 0, 1.f};
        gemm_big(F, (const bf16*)(ws + WS0_PROJ), LDP0, (const bf16*)(ws + W0_OUT), M, DM, 2048, E); }
    SEAM(6);
    if (IN(7)) rowpass<true, true>(F, F.x, (const bf16*)(ws + WS0_XN), mod + 2048, F.norm_g + 1024, F.out, F.norm_g + 2048, mod + 3072, mod + 4096, (bf16*)(ws + WS0_XN));
    SEAM(7);
    if (IN(8)) { EpiRelu2 E{(bf16*)(ws + WS0_U), FF}; gemm_big(F, (const bf16*)(ws + WS0_XN), DM, (const bf16*)(ws + W0_W1), M, FF, DM, E); }
    SEAM(8);
    if (IN(9)) { EpiBf16 E{(bf16*)(ws + WS0_MLPOUT), DM, 0, 0, 1.f}; gemm_big(F, (const bf16*)(ws + WS0_U), FF, (const bf16*)(ws + W0_W2), M, DM, FF, E); }
    SEAM(9);
    if (IN(10)) {
        rowpass<true, true>(F, F.out, (const bf16*)(ws + WS0_MLPOUT), mod + 5120, F.norm_g + 3072, F.out, F.norm_g + 4096, mod + 4 * 6144, mod + 4 * 6144 + 1024, (bf16*)(ws + WS1_XN));
        const TrJob jobs[4] = {
            {F.ml_w_in, 1024, MLIN, 0, 4096, (bf16*)(ws + W1_QKV)},
            {F.ml_w_in, 1024, MLIN, 4096, 2048, (bf16*)(ws + W1_O)},
            {F.ml_w_in, 1024, MLIN, 6144, 32, (bf16*)(ws + W1_G)},
            {F.ml_w_out, 2048, 1024, 0, 1024, (bf16*)(ws + W1_OUT)}};
        transpose_jobs(F, jobs);
    }
    SEAM(10);
    if (IN(11)) {
        EpiBf16 E{(bf16*)(ws + WS1_PROJ), LDP1, 0, 1024, 0.08838834764831845f};
        gemm_big(F, (const bf16*)(ws + WS1_XN), DM, (const bf16*)(ws + W1_QKV), M, 4096, DM, E);
        EpiGates Eg{(float*)(ws + WS1_GATES), F.gate_b};
        gemm_simple(F, (const bf16*)(ws + WS1_XN), DM, (const bf16*)(ws + W1_G), M, 32, DM, Eg);
    }
    SEAM(11);
#if USE_MLSTM_CHUNK
    if (IN(12)) { for (int it = blockIdx.x; it < 256; it += F.G) mlstm_chunk_item(F, it, 0); }
#else
    if (IN(12)) { if ((int)blockIdx.x < 32) mlstm_simple_item(F, blockIdx.x, 0); }
#endif
    SEAM(12);
#if USE_MLSTM_CHUNK
    if (IN(13)) { for (int it = blockIdx.x; it < 256; it += F.G) mlstm_chunk_item(F, it, 1); }
#else
    if (IN(13)) { if ((int)blockIdx.x < 32) mlstm_simple_item(F, blockIdx.x, 1); }
#endif
    SEAM(13);
    if (IN(14)) headstat_phase(F);
    SEAM(14);
    if (IN(15)) { EpiOGate E{(bf16*)(ws + WS1_H), (const float*)(ws + WS1_RS), F.head_norm};
        gemm_big(F, (const bf16*)(ws + WS1_XN), DM, (const bf16*)(ws + W1_O), M, 2048, DM, E); }
    SEAM(15);
    if (IN(16)) { EpiBf16 E{(bf16*)(ws + WS1_MIX), DM, 0, 0, 1.f}; gemm_big(F, (const bf16*)(ws + WS1_H), 2048, (const bf16*)(ws + W1_OUT), M, DM, 2048, E); }
    SEAM(16);
    if (IN(17)) {
        rowpass<true, true>(F, F.out, (const bf16*)(ws + WS1_MIX), mod + 4 * 6144 + 2048, F.norm_g + 4096 + 1024, F.out, F.norm_g + 4096 + 2048, mod + 4 * 6144 + 3072, mod + 4 * 6144 + 4096, (bf16*)(ws + WS1_XN));
        const TrJob jobs[2] = {
            {F.mlp_w1 + (size_t)1024 * FF, 1024, FF, 0, FF, (bf16*)(ws + W1_W1)},
            {F.mlp_w2 + (size_t)FF * 1024, FF, 1024, 0, 1024, (bf16*)(ws + W1_W2)}};
        transpose_jobs(F, jobs);
    }
    SEAM(17);
    if (IN(18)) { EpiRelu2 E{(bf16*)(ws + WS1_U), FF}; gemm_big(F, (const bf16*)(ws + WS1_XN), DM, (const bf16*)(ws + W1_W1), M, FF, DM, E); }
    SEAM(18);
    if (IN(19)) { EpiBf16 E{(bf16*)(ws + WS1_MLPOUT), DM, 0, 0, 1.f}; gemm_big(F, (const bf16*)(ws + WS1_U), FF, (const bf16*)(ws + W1_W2), M, DM, FF, E); }
    SEAM(19);
    if (IN(20)) rowpass<true, false>(F, F.out, (const bf16*)(ws + WS1_MLPOUT), mod + 4 * 6144 + 5120, F.norm_g + 4096 + 3072, F.out, nullptr, nullptr, nullptr, nullptr);
#undef IN
#undef SEAM
}

extern "C" void kernel_launch(void* const* d_in, const int* in_sizes, int n_in, void* d_out, int out_size, void* d_ws, size_t ws_size, hipStream_t stream) {
    static int grid = 0;
    if (grid == 0) {
        if (n_in != 20 || out_size != M * DM || ws_size < WS_END) { fprintf(stderr, "kernel_launch: unexpected problem shape (n_in %d out %d ws %zu)\n", n_in, out_size, ws_size); grid = -1; return; }
        int dev = 0, cus = 0;
        if (hipGetDevice(&dev) != hipSuccess || hipDeviceGetAttribute(&cus, hipDeviceAttributeMultiprocessorCount, dev) != hipSuccess) { grid = -1; return; }
        if (hipFuncSetAttribute((const void*)mega_fwd, hipFuncAttributeMaxDynamicSharedMemorySize, LDS_BYTES) != hipSuccess) { fprintf(stderr, "kernel_launch: hipFuncSetAttribute failed\n"); grid = -1; return; }
        int per_cu = 0;
        if (hipOccupancyMaxActiveBlocksPerMultiprocessor(&per_cu, (const void*)mega_fwd, NTHREADS, LDS_BYTES) != hipSuccess || per_cu < 1) fprintf(stderr, "kernel_launch: occupancy query says %d\n", per_cu);
        (void)hipGetLastError();
        grid = cus;
    }
    if (grid < 0) return;
    (void)hipMemsetAsync((char*)d_ws + WS_CTL, 0, CTL_ZERO_BYTES, stream);
    Args a{};
    for (int i = 0; i < 20; ++i) a.in[i] = (const float*)d_in[i];
    a.out = (float*)d_out; a.ws = (unsigned char*)d_ws;
#if MK_ONE_LAUNCH
    a.ph_lo = 0; a.ph_hi = NPHASE;
    hipLaunchKernelGGL(mega_fwd, dim3(grid), dim3(NTHREADS), LDS_BYTES, stream, a);
#else
    for (int p = 0; p < NPHASE; ++p) { a.ph_lo = p; a.ph_hi = p + 1; hipLaunchKernelGGL(mega_fwd, dim3(grid), dim3(NTHREADS), LDS_BYTES, stream, a); }
#endif
}
```

```cpp
#include <hip/hip_runtime.h>
#include <cstdio>
#include <cstdint>

#define GAS __attribute__((address_space(1)))
#define LAS __attribute__((address_space(3)))
typedef unsigned short bf16;
typedef short bf16x8 __attribute__((ext_vector_type(8)));
typedef float f32x4 __attribute__((ext_vector_type(4)));
typedef unsigned u32x4 __attribute__((ext_vector_type(4)));
typedef unsigned u32x2 __attribute__((ext_vector_type(2)));

#ifndef USE_MLSTM_CHUNK
#define USE_MLSTM_CHUNK 1
#endif
#ifndef USE_SSD_CHUNK
#define USE_SSD_CHUNK 1
#endif
#ifndef PROBE_MASK
#define PROBE_MASK 0u
#define PROBE_MULT 2
#endif
#ifndef PROBE_SUB
#define PROBE_SUB 0
#endif
#ifndef USE_NA_MFMA
#define USE_NA_MFMA 1
#endif
#ifndef USE_PG8
#define USE_PG8 1
#endif
#ifndef MK_ONE_LAUNCH
#define MK_ONE_LAUNCH 1
#endif

constexpr int NWAVES = 8, NTHREADS = 512;
constexpr int BATCH = 4, SEQ = 4096, DM = 1024, M = BATCH * SEQ, FF = 4096;
constexpr float EPS = 1e-6f;
constexpr int SH = 16, SP = 64, SN = 128, CONVCH = 1536, ABIN = 5664;
constexpr int LDP0 = 5632, P0_Z = 0, P0_Q = 1024, P0_K = 2048, P0_V = 3072, P0_XBC = 4096;
constexpr int MH = 8, MDK = 128, MDV = 256, MLIN = 6176, LDP1 = 4096, P1_Q = 0, P1_K = 1024, P1_V = 2048;
constexpr int NPHASE = 21;

constexpr size_t MiB = 1u << 20;
constexpr size_t WS_CTL = 0, CTL_ZERO_BYTES = 1 * MiB;
constexpr size_t WS_MOD = 1 * MiB;
constexpr size_t W0_IN = 2 * MiB, W0_DT = 13 * MiB, W0_OUT = 14 * MiB, W0_W1 = 18 * MiB, W0_W2 = 26 * MiB;
constexpr size_t WS0_XN = 36 * MiB, WS0_DT = 68 * MiB, WS0_PROJ = 70 * MiB, WS0_U = 70 * MiB, WS0_MLPOUT = 198 * MiB;
constexpr size_t W1_QKV = 2 * MiB, W1_O = 10 * MiB, W1_G = 14 * MiB, W1_OUT = 15 * MiB, W1_W1 = 2 * MiB, W1_W2 = 10 * MiB;
constexpr size_t WS1_GATES = 19 * MiB, WS1_XN = 21 * MiB, WS1_PROJ = 53 * MiB, WS1_H = 181 * MiB, WS1_RS = 245 * MiB;
constexpr size_t WS1_GV = 246 * MiB;
constexpr size_t WS0_CS = 246 * MiB;
constexpr size_t WS1_MIX = 53 * MiB, WS1_U = 53 * MiB, WS1_MLPOUT = 181 * MiB;
constexpr size_t WS_END = 256 * MiB;
constexpr size_t DO_XBC = 0;

constexpr int LDS_BYTES = 163840;

__device__ __forceinline__ float bf2f(unsigned v) { return __uint_as_float(v << 16); }
__device__ __forceinline__ unsigned f2bf(float f) { unsigned u = __float_as_uint(f); return (u + 0x7fffu + ((u >> 16) & 1u)) >> 16; }
typedef __bf16 hwbf16x2 __attribute__((ext_vector_type(2)));
typedef float cvf32x2 __attribute__((ext_vector_type(2)));
__device__ __forceinline__ unsigned pk2(float lo, float hi) { const cvf32x2 v = {lo, hi}; return __builtin_bit_cast(unsigned, __builtin_convertvector(v, hwbf16x2)); }
__device__ __forceinline__ float bflo(unsigned w) { return __uint_as_float(w << 16); }
__device__ __forceinline__ float bfhi(unsigned w) { return __uint_as_float(w & 0xffff0000u); }
__device__ __forceinline__ float wave_sum(float v) {
#pragma unroll
    for (int o = 1; o < 64; o <<= 1) v += __shfl_xor(v, o);
    return v;
}
__device__ __forceinline__ float silu_f(float x) { return x / (1.f + __expf(-x)); }
__device__ __forceinline__ float sigmoid_f(float x) { return 1.f / (1.f + __expf(-x)); }
__device__ __forceinline__ float softplus_f(float x) { return x > 20.f ? x : log1pf(__expf(x)); }

#define XB_TMO      128
#define XB_XCNT(j)  (256  + 64 * (j))
#define XB_XSUB(j)  (1280 + 64 * (j))
#define XB_XGEN(j)  (2304 + 64 * (j))
#define XB_TOP      3328
#define XB_TOPGEN   3392
#define XCD_BAR_WORDS 3456
#define XB_SPIN_CAP (1u << 22)
__device__ __forceinline__ unsigned xb_ld(unsigned* p)              { return __hip_atomic_load(p, __ATOMIC_RELAXED, __HIP_MEMORY_SCOPE_AGENT); }
__device__ __forceinline__ unsigned xb_add(unsigned* p, unsigned v) { return __hip_atomic_fetch_add(p, v, __ATOMIC_RELAXED, __HIP_MEMORY_SCOPE_AGENT); }
__device__ __forceinline__ unsigned xb_xcc_id() { return (unsigned)__builtin_amdgcn_s_getreg((3 << 11) | 20) & 0xFu; }
#define XB_SPIN(cond, bar) do { unsigned _sp = 0; while (cond) { __builtin_amdgcn_s_sleep(1); \
    if ((++_sp & 255u) == 0u) { if (xb_ld(&(bar)[XB_TMO])) break; if (_sp > XB_SPIN_CAP) { atomicAdd(&(bar)[XB_TMO], 1u); break; } } } } while (0)
struct XcdBarrier { unsigned* bar; unsigned x; volatile LAS unsigned* st; };
__device__ __forceinline__ XcdBarrier xcd_barrier_post(unsigned* bar, volatile LAS unsigned* st) {
    XcdBarrier b; b.bar = bar; b.x = xb_xcc_id(); b.st = st;
    if (threadIdx.x == 0) (void)xb_add(&bar[XB_XCNT(b.x)], 1u);
    return b;
}
__device__ __forceinline__ void xcd_barrier_complete(unsigned* bar, unsigned x, unsigned& nloc, unsigned& nx) {
    const unsigned G = gridDim.x * gridDim.y * gridDim.z;
    unsigned sum, cnt, mine, sp = 0u;
    for (;;) {
        sum = 0u; cnt = 0u; mine = 0u;
#pragma unroll
        for (unsigned j = 0; j < 16; ++j) { const unsigned c = xb_ld(&bar[XB_XCNT(j)]); sum += c; cnt += (c > 0u) ? 1u : 0u; mine = (j == x) ? c : mine; }
        if (sum == G) break;
        __builtin_amdgcn_s_sleep(1);
        if ((++sp & 255u) == 0u) { if (xb_ld(&bar[XB_TMO])) break; if (sp > XB_SPIN_CAP) { atomicAdd(&bar[XB_TMO], 1u); break; } }
    }
    nloc = mine > 0u ? mine : 1u; nx = cnt > 0u ? cnt : 1u;
}
__device__ __forceinline__ void xcd_barrier(const XcdBarrier& b) {
    asm volatile("s_waitcnt vmcnt(0)" ::: "memory");
    __syncthreads();
    if (threadIdx.x == 0) {
        unsigned* bar = b.bar;
        __builtin_amdgcn_s_waitcnt(0);
        unsigned nloc = b.st[0], nx = b.st[1];
        if (nloc == 0u) { xcd_barrier_complete(bar, b.x, nloc, nx); b.st[0] = nloc; b.st[1] = nx; }
        const unsigned old = xb_add(&bar[XB_XSUB(b.x)], 1u);
        const unsigned gen = old / nloc;
        if (old + 1u == (gen + 1u) * nloc) {
            __builtin_amdgcn_fence(__ATOMIC_RELEASE, "agent");
            asm volatile("s_waitcnt vmcnt(0)" ::: "memory");
            const unsigned og = xb_add(&bar[XB_TOP], 1u);
            const unsigned tg = og / nx;
            if (og + 1u == (tg + 1u) * nx) xb_add(&bar[XB_TOPGEN], 1u);
            else XB_SPIN(xb_ld(&bar[XB_TOPGEN]) == tg, bar);
            __builtin_amdgcn_fence(__ATOMIC_ACQUIRE, "agent");
            xb_add(&bar[XB_XGEN(b.x)], 1u);
            asm volatile("s_waitcnt vmcnt(0)" ::: "memory");
        } else {
            XB_SPIN(xb_ld(&bar[XB_XGEN(b.x)]) == gen, bar);
            __builtin_amdgcn_fence(__ATOMIC_ACQUIRE, "agent");
            asm volatile("s_waitcnt vmcnt(0)" ::: "memory");
        }
    }
    __syncthreads();
}

struct Args { const float* in[20]; float* out; unsigned char* ws; int ph_lo, ph_hi; };
struct Frame {
    LAS unsigned char* lds;
    int tid, lane, wave, G, vcu;
    const float *x, *c, *ada_w, *ada_b, *norm_g, *mlp_w1, *mlp_w2, *ab_w_in, *conv_w, *conv_b, *dt_bias, *a_log, *d_skip, *ssd_norm, *rpb, *ab_w_out,
                *ml_w_in, *gate_b, *head_norm, *ml_w_out;
    float* out; unsigned char* ws; unsigned long long tacc;
};

__device__ __forceinline__ bool phase_begin(Frame& F) { int t_ = threadIdx.x; asm volatile("" : "+v"(t_)); F.tid = t_; F.lane = t_ & 63; return true; }
__device__ __forceinline__ void transpose_item(const float* W, int K, int ldw, int c0, int ncols, bf16* WT, LAS float* scr, int item, int lane) {
    const int nblk = ncols / 32, kb = item / nblk, nb = item % nblk, k0 = 64 * kb, n0 = 32 * nb;
#pragma unroll 8
    for (int i = 0; i < 32; ++i) { const int kk = 2 * i + (lane >> 5); scr[kk * 33 + (lane & 31)] = W[(size_t)(k0 + kk) * ldw + c0 + n0 + (lane & 31)]; }
    asm volatile("s_waitcnt lgkmcnt(0)" ::: "memory");
    const int c = lane & 7;
#pragma unroll
    for (int j = 0; j < 4; ++j) { const int n = (lane >> 3) + 8 * j; const LAS float* s = scr + (8 * c) * 33 + n;
        u32x4 o; o.x = pk2(s[0 * 33], s[1 * 33]); o.y = pk2(s[2 * 33], s[3 * 33]); o.z = pk2(s[4 * 33], s[5 * 33]); o.w = pk2(s[6 * 33], s[7 * 33]);
        *(u32x4*)(WT + (size_t)(n0 + n) * K + k0 + 8 * c) = o; }
    asm volatile("s_waitcnt lgkmcnt(0)" ::: "memory");
}
struct TrJob { const float* W; int K, ldw, c0, ncols; bf16* WT; };
template <int NJ> __device__ __forceinline__ void transpose_jobs(Frame& F, const TrJob (&jobs)[NJ]) {
    LAS float* scr = (LAS float*)(F.lds + F.wave * 16384);
    const int gw = F.vcu * NWAVES + F.wave, NGW = F.G * NWAVES;
    int base = 0;
#pragma unroll
    for (int j = 0; j < NJ; ++j) {
        const int nitems = (jobs[j].K / 64) * (jobs[j].ncols / 32);
        int first = gw - (base % NGW); if (first < 0) first += NGW;
        for (int it = first; it < nitems; it += NGW) transpose_item(jobs[j].W, jobs[j].K, jobs[j].ldw, jobs[j].c0, jobs[j].ncols, jobs[j].WT, scr, it, F.lane);
        base += nitems;
    }
}

__device__ __forceinline__ void mod_phase(Frame& F) {
    float* mod = (float*)(F.ws + WS_MOD);
    LAS float* red = (LAS float*)F.lds;
    for (int item = blockIdx.x; item < 2 * 96; item += F.G) {
        const int l = item / 96, cg = item % 96, col = cg * 64 + F.lane, kg = F.wave;
        float acc0 = 0.f, acc1 = 0.f, acc2 = 0.f, acc3 = 0.f;
        const float* w = F.ada_w + ((size_t)l * 1024 + kg * 128) * 6144 + col;
        const float* cc = F.c + kg * 128;
#pragma unroll 4
        for (int k = 0; k < 128; ++k) {
            const float wv = w[(size_t)k * 6144];
            acc0 += silu_f(cc[k]) * wv; acc1 += silu_f(cc[1024 + k]) * wv; acc2 += silu_f(cc[2048 + k]) * wv; acc3 += silu_f(cc[3072 + k]) * wv;
        }
        red[(kg * 4 + 0) * 64 + F.lane] = acc0; red[(kg * 4 + 1) * 64 + F.lane] = acc1; red[(kg * 4 + 2) * 64 + F.lane] = acc2; red[(kg * 4 + 3) * 64 + F.lane] = acc3;
        __syncthreads();
        if (F.tid < 256) { const int b = F.tid >> 6, ln = F.tid & 63; float s = 0.f;
#pragma unroll
            for (int g = 0; g < 8; ++g) s += red[(g * 4 + b) * 64 + ln];
            mod[((size_t)l * 4 + b) * 6144 + cg * 64 + ln] = s + F.ada_b[l * 6144 + cg * 64 + ln]; }
        __syncthreads();
    }
}

template <bool HAS_MIX, bool HAS_XN>
__device__ __forceinline__ void rowpass(Frame& F, const float* xin, const bf16* mix, const float* gate, const float* ng_mix, float* xout,
                                        const float* ng_x, const float* sh, const float* sc, bf16* xn) {
    const int gw = F.vcu * NWAVES + F.wave, NGW = F.G * NWAVES;
    for (int m = gw; m < M; m += NGW) {
        const int b = m / SEQ;
        f32x4 v[4];
#pragma unroll
        for (int j = 0; j < 4; ++j) v[j] = *(const f32x4*)(xin + (size_t)m * DM + 4 * F.lane + 256 * j);
        if (HAS_MIX) {
            f32x4 mv[4]; float ss = 0.f;
#pragma unroll
            for (int j = 0; j < 4; ++j) { const u32x2 w = *(const u32x2*)(mix + (size_t)m * DM + 4 * F.lane + 256 * j);
                mv[j] = (f32x4){bflo(w.x), bfhi(w.x), bflo(w.y), bfhi(w.y)}; ss += (mv[j].x * mv[j].x + mv[j].y * mv[j].y) + (mv[j].z * mv[j].z + mv[j].w * mv[j].w); }
            const float rstd = rsqrtf(wave_sum(ss) * (1.f / DM) + EPS);
#pragma unroll
            for (int j = 0; j < 4; ++j) { const int c = 4 * F.lane + 256 * j; const f32x4 g = *(const f32x4*)(gate + (size_t)b * 6144 + c), ng = *(const f32x4*)(ng_mix + c);
                v[j] = v[j] + g * (mv[j] * rstd * ng); *(f32x4*)(xout + (size_t)m * DM + c) = v[j]; }
        }
        if (HAS_XN) {
            float ss = 0.f;
#pragma unroll
            for (int j = 0; j < 4; ++j) ss += (v[j].x * v[j].x + v[j].y * v[j].y) + (v[j].z * v[j].z + v[j].w * v[j].w);
            const float rstd = rsqrtf(wave_sum(ss) * (1.f / DM) + EPS);
#pragma unroll
            for (int j = 0; j < 4; ++j) { const int c = 4 * F.lane + 256 * j; const f32x4 ng = *(const f32x4*)(ng_x + c), s1 = *(const f32x4*)(sc + (size_t)b * 6144 + c), s0 = *(const f32x4*)(sh + (size_t)b * 6144 + c);
                const f32x4 o = (v[j] * rstd * ng) * (s1 + 1.f) + s0; u32x2 w; w.x = pk2(o.x, o.y); w.y = pk2(o.z, o.w);
                *(u32x2*)(xn + (size_t)m * DM + c) = w; }
        }
    }
}

template <class Epi>
__device__ __forceinline__ void gemm_simple(Frame& F, const bf16* A, int lda, const bf16* Bt, int Mr, int N, int K, const Epi& E) {
    const int gw = F.vcu * NWAVES + F.wave, NGW = F.G * NWAVES;
    const int tn_n = N / 32, ntiles = (Mr / 32) * tn_n;
    const int fr = F.lane & 15, fq = F.lane >> 4;
    for (int t = gw; t < ntiles; t += NGW) {
        const int tm = t / tn_n, tn = t % tn_n, m0 = tm * 32, n0 = tn * 32;
        f32x4 acc[2][2];
#pragma unroll
        for (int i = 0; i < 2; ++i)
#pragma unroll
            for (int j = 0; j < 2; ++j) acc[i][j] = (f32x4){0.f, 0.f, 0.f, 0.f};
        const bf16* ap = A + (size_t)(m0 + fr) * lda + fq * 8;
        const bf16* bp = Bt + (size_t)(n0 + fr) * K + fq * 8;
#pragma unroll 2
        for (int k0 = 0; k0 < K; k0 += 32) {
            const bf16x8 a0 = *(const bf16x8*)(ap + k0), a1 = *(const bf16x8*)(ap + (size_t)16 * lda + k0);
            const bf16x8 b0 = *(const bf16x8*)(bp + k0), b1 = *(const bf16x8*)(bp + (size_t)16 * K + k0);
            acc[0][0] = __builtin_amdgcn_mfma_f32_16x16x32_bf16(b0, a0, acc[0][0], 0, 0, 0);
            acc[0][1] = __builtin_amdgcn_mfma_f32_16x16x32_bf16(b1, a0, acc[0][1], 0, 0, 0);
            acc[1][0] = __builtin_amdgcn_mfma_f32_16x16x32_bf16(b0, a1, acc[1][0], 0, 0, 0);
            acc[1][1] = __builtin_amdgcn_mfma_f32_16x16x32_bf16(b1, a1, acc[1][1], 0, 0, 0);
        }
#pragma unroll
        for (int i = 0; i < 2; ++i)
#pragma unroll
            for (int j = 0; j < 2; ++j) E.put4(m0 + 16 * i + fr, n0 + 16 * j + 4 * fq, acc[i][j]);
    }
}
struct EpiBf16 {
    bf16* O; int ldc; int sc0, sc1; float scale;
    __device__ __forceinline__ void put4(int row, int col, f32x4 v) const {
        if (col >= sc0 && col < sc1) v = v * scale;
        u32x2 w; w.x = pk2(v.x, v.y); w.y = pk2(v.z, v.w); *(u32x2*)(O + (size_t)row * ldc + col) = w; }
};
struct EpiRelu2 {
    bf16* O; int ldc;
    __device__ __forceinline__ void put4(int row, int col, f32x4 v) const {
        v.x = fmaxf(v.x, 0.f); v.y = fmaxf(v.y, 0.f); v.z = fmaxf(v.z, 0.f); v.w = fmaxf(v.w, 0.f); v = v * v;
        u32x2 w; w.x = pk2(v.x, v.y); w.y = pk2(v.z, v.w); *(u32x2*)(O + (size_t)row * ldc + col) = w; }
};
struct EpiDt {
    float* O; const float* bias;
    __device__ __forceinline__ void put4(int row, int col, f32x4 v) const {
        const f32x4 b = *(const f32x4*)(bias + col); f32x4 o;
        o.x = softplus_f(v.x + b.x); o.y = softplus_f(v.y + b.y); o.z = softplus_f(v.z + b.z); o.w = softplus_f(v.w + b.w);
        *(f32x4*)(O + (size_t)row * 32 + col) = o; }
};
struct EpiGates {
    float* O; const float* bias;
    __device__ __forceinline__ void put4(int row, int col, f32x4 v) const { *(f32x4*)(O + (size_t)row * 32 + col) = v + *(const f32x4*)(bias + col); }
};
struct EpiOGate {
    bf16* H; const float* RS; const float* hg;
    __device__ __forceinline__ void put4(int row, int col, f32x4 v) const {
        bf16* p = H + (size_t)row * 2048 + col; const u32x2 w = *(const u32x2*)p; const float rs = RS[(size_t)row * 8 + (col >> 8)]; const f32x4 g = *(const f32x4*)(hg + col);
        f32x4 o; o.x = sigmoid_f(v.x) * bflo(w.x) * rs * g.x; o.y = sigmoid_f(v.y) * bfhi(w.x) * rs * g.y; o.z = sigmoid_f(v.z) * bflo(w.y) * rs * g.z; o.w = sigmoid_f(v.w) * bfhi(w.y) * rs * g.w;
        u32x2 r; r.x = pk2(o.x, o.y); r.y = pk2(o.z, o.w); *(u32x2*)p = r; }
};

namespace pg8 {
constexpr int BM = 256, BK = 64, HALF = 128, HTB = HALF * BK * 2, STAGE_BYTES = 8 * HTB, NXCD = 8, WGM = 8;
__host__ __device__ __forceinline__ int lds_byte(int r, int c) { const int st = (r >> 4) * 2 + (c >> 5), rr = r & 15, cc = c & 31, ob = rr * 64 + cc * 2; return st * 1024 + (ob ^ (((ob >> 9) & 1) << 5)); }
__host__ __device__ __forceinline__ void stage_rc(int b, int& R, int& C) { const int st = b / 1024, sb = b % 1024, swz = sb ^ (((sb >> 9) & 1) << 5); R = (st >> 1) * 16 + swz / 64; C = (st & 1) * 32 + (swz % 64) / 2; }
struct Unit { int pm, pn; };
struct Gemm { const bf16* A; int lda; const bf16* Bt; int M, N, K; };
struct StaticOrder {
    int nM, nN, nwg, G, c;
    __host__ __device__ void init(int M_, int N_, int G_, int c_) { nM = M_ / BM; nN = N_ / BM; nwg = nM * nN; G = G_; c = c_; }
    __host__ __device__ bool next(int i, Unit& u) const {
        const long L = (long)i * G + c; if (L >= nwg) return false;
        int wgid = (int)L; { const int q = nwg / NXCD, r = nwg % NXCD, xcd = wgid % NXCD, off = wgid / NXCD; wgid = (xcd < r ? xcd * (q + 1) : r * (q + 1) + (xcd - r) * q) + off; }
        const int nig = WGM * nN, gid = wgid / nig, fm = gid * WGM, gsz = (nM - fm) < WGM ? (nM - fm) : WGM;
        u.pm = fm + ((wgid % nig) % gsz); u.pn = (wgid % nig) / gsz; return true;
    }
};
template <class Epi, bool ALIGN_EPI = true>
__device__ __forceinline__ void gemm_phase(LAS unsigned char* lds, const Gemm g, const StaticOrder& S, const Epi& E) {
    const int tid = threadIdx.x, wid = __builtin_amdgcn_readfirstlane(tid >> 6), lane = tid & 63, wr = wid >> 2, wc = wid & 3, fr = lane & 15, fq = lane >> 4;
    const int K = g.K, nt = K / BK, lda = g.lda;
    unsigned voffA[2], voffB[2];
#pragma unroll
    for (int i = 0; i < 2; ++i) { int R, C; stage_rc(tid * 16 + i * 8192, R, C); voffA[i] = (unsigned)(R * lda + C) * 2u; voffB[i] = (unsigned)(R * K + C) * 2u; }
    const size_t kstep = (size_t)(BK * 2);
    const size_t hstepA = (size_t)HALF * lda * 2, hstepB = (size_t)HALF * K * 2;
    const size_t tstepA = 2 * hstepA, tstepB = 2 * hstepB;
    const unsigned ldsw = (unsigned)wid * 1024u;
    const int aoff = lds_byte(wr * 64 + fr, fq * 8), boff = lds_byte(wc * 32 + fr, fq * 8);
#define PG8_SA(b, h) (((b) * 2 + (h)) * HTB)
#define PG8_SB(b, h) ((4 + (b) * 2 + (h)) * HTB)
#define PG8_STAGE(bufoff, gbase, voff) do { _Pragma("unroll") for (int _i = 0; _i < 2; ++_i) \
        __builtin_amdgcn_global_load_lds((const unsigned*)((const char*)(gbase) + (voff)[_i]), (LAS unsigned*)(lds + (bufoff) + ldsw + _i * 8192), 16, 0, 0); } while (0)
#define PG8_LDA(dst, b, h) do { _Pragma("unroll") for (int m = 0; m < 4; ++m) _Pragma("unroll") for (int k = 0; k < 2; ++k) dst[m][k] = *(const LAS bf16x8*)(lds + PG8_SA(b, h) + aoff + m * 2048 + k * 1024); } while (0)
#define PG8_LDB(dst, b, h) do { _Pragma("unroll") for (int n = 0; n < 2; ++n) _Pragma("unroll") for (int k = 0; k < 2; ++k) dst[n][k] = *(const LAS bf16x8*)(lds + PG8_SB(b, h) + boff + n * 2048 + k * 1024); } while (0)
#define PG8_MMA(ai, bj, At, Bt) do { __builtin_amdgcn_s_setprio(1); _Pragma("unroll") for (int m = 0; m < 4; ++m) _Pragma("unroll") for (int n = 0; n < 2; ++n) _Pragma("unroll") for (int k = 0; k < 2; ++k) \
        acc[ai][bj][m][n] = __builtin_amdgcn_mfma_f32_16x16x32_bf16(Bt[n][k], At[m][k], acc[ai][bj][m][n], 0, 0, 0); __builtin_amdgcn_s_setprio(0); } while (0)
#define PG8_WAIT_V(n) asm volatile("s_waitcnt vmcnt(" #n ")" ::: "memory")
#define PG8_WAIT_L(n) asm volatile("s_waitcnt lgkmcnt(" #n ")" ::: "memory")
#define PG8_BAR __builtin_amdgcn_s_barrier()
#define PG8_SCHED __builtin_amdgcn_sched_barrier(0)
    Unit cur, nxt; int ui = 0;
    if (!S.next(0, cur)) return;
    f32x4 acc[2][2][4][2];
#pragma unroll
    for (int a = 0; a < 2; ++a)
#pragma unroll
        for (int b = 0; b < 2; ++b)
#pragma unroll
            for (int m = 0; m < 4; ++m)
#pragma unroll
                for (int n = 0; n < 2; ++n) acc[a][b][m][n] = (f32x4){0.f, 0.f, 0.f, 0.f};
    bf16x8 At[4][2], B0[2][2], B1[2][2];
    const char* cA = (const char*)g.A + (size_t)cur.pm * tstepA; const char* cB = (const char*)g.Bt + (size_t)cur.pn * tstepB;
    PG8_STAGE(PG8_SB(0, 0), cB, voffB); PG8_STAGE(PG8_SB(0, 1), cB + hstepB, voffB); PG8_STAGE(PG8_SA(0, 0), cA, voffA); PG8_STAGE(PG8_SA(0, 1), cA + hstepA, voffA);
    if (wr == 1) PG8_BAR;
    PG8_WAIT_V(2); PG8_BAR;
    PG8_STAGE(PG8_SB(1, 0), cB + kstep, voffB); PG8_STAGE(PG8_SA(1, 0), cA + kstep, voffA); PG8_STAGE(PG8_SB(1, 1), cB + hstepB + kstep, voffB);
    PG8_WAIT_V(6); PG8_BAR;
    for (;;) {
        const bool has_next = S.next(ui + 1, nxt);
        const char* nA = has_next ? (const char*)g.A + (size_t)nxt.pm * tstepA : cA; const char* nB = has_next ? (const char*)g.Bt + (size_t)nxt.pn * tstepB : cB;
        for (int t = 0; t < nt; t += 2) {
            const bool last = (t == nt - 2);
            const char* a1 = cA + (size_t)(t + 1) * kstep;
            const char* a2 = last ? nA : cA + (size_t)(t + 2) * kstep; const char* b2 = last ? nB : cB + (size_t)(t + 2) * kstep;
            const char* a3 = a2 + kstep; const char* b3 = b2 + kstep;
            PG8_LDB(B0, 0, 0); PG8_LDB(B1, 0, 1); PG8_SCHED; PG8_LDA(At, 0, 0); PG8_STAGE(PG8_SA(1, 1), a1 + hstepA, voffA);
            PG8_WAIT_V(8); PG8_WAIT_L(0); PG8_BAR; PG8_MMA(0, 0, At, B0); PG8_MMA(0, 1, At, B1); PG8_BAR; PG8_SCHED;
            PG8_LDA(At, 0, 1); PG8_STAGE(PG8_SB(0, 0), b2, voffB); PG8_STAGE(PG8_SB(0, 1), b2 + hstepB, voffB); PG8_STAGE(PG8_SA(0, 0), a2, voffA);
            PG8_WAIT_V(8); PG8_WAIT_L(0); PG8_BAR; PG8_MMA(1, 0, At, B0); PG8_MMA(1, 1, At, B1); PG8_BAR; PG8_SCHED;
            PG8_LDB(B0, 1, 0); PG8_LDB(B1, 1, 1); PG8_SCHED; PG8_LDA(At, 1, 0); PG8_STAGE(PG8_SA(0, 1), a2 + hstepA, voffA);
            PG8_WAIT_V(8); PG8_WAIT_L(0); PG8_BAR; PG8_MMA(0, 0, At, B0); PG8_MMA(0, 1, At, B1); PG8_BAR; PG8_SCHED;
            PG8_LDA(At, 1, 1); PG8_STAGE(PG8_SB(1, 0), b3, voffB); PG8_STAGE(PG8_SB(1, 1), b3 + hstepB, voffB); PG8_STAGE(PG8_SA(1, 0), a3, voffA);
            PG8_WAIT_V(8); PG8_WAIT_L(0); PG8_BAR; PG8_MMA(1, 0, At, B0); PG8_MMA(1, 1, At, B1); PG8_BAR; PG8_SCHED;
        }
        if constexpr (ALIGN_EPI) { if (wr == 0) PG8_BAR; }
        {
            const int row0 = cur.pm * BM + wr * 64 + fr, col0 = cur.pn * BM + wc * 32 + 4 * fq;
#pragma unroll
            for (int ai = 0; ai < 2; ++ai)
#pragma unroll
                for (int m = 0; m < 4; ++m)
#pragma unroll
                    for (int bj = 0; bj < 2; ++bj)
#pragma unroll
                        for (int n = 0; n < 2; ++n) E.put4(row0 + ai * HALF + m * 16, col0 + bj * HALF + n * 16, acc[ai][bj][m][n]);
        }
        if (!has_next) break;
#pragma unroll
        for (int a = 0; a < 2; ++a)
#pragma unroll
            for (int b = 0; b < 2; ++b)
#pragma unroll
                for (int m = 0; m < 4; ++m)
#pragma unroll
                    for (int n = 0; n < 2; ++n) acc[a][b][m][n] = (f32x4){0.f, 0.f, 0.f, 0.f};
        cur = nxt; cA = nA; cB = nB; ++ui;
        if constexpr (ALIGN_EPI) { if (wr == 1) PG8_BAR; }
    }
    PG8_WAIT_V(0);
    if constexpr (!ALIGN_EPI) { if (wr == 0) PG8_BAR; }
    PG8_BAR;
#undef PG8_SA
#undef PG8_SB
#undef PG8_STAGE
#undef PG8_LDA
#undef PG8_LDB
#undef PG8_MMA
#undef PG8_WAIT_V
#undef PG8_WAIT_L
#undef PG8_BAR
#undef PG8_SCHED
}
}
template <class Epi>
__device__ __forceinline__ void gemm_big(Frame& F, const bf16* A, int lda, const bf16* Bt, int Mr, int N, int K, const Epi& E) {
#if USE_PG8
    pg8::Gemm g{A, lda, Bt, Mr, N, K}; pg8::StaticOrder S; S.init(Mr, N, F.G, (int)blockIdx.x);
    pg8::gemm_phase<Epi, true>(F.lds, g, S, E);
    __syncthreads();
#else
    gemm_simple(F, A, lda, Bt, Mr, N, K, E);
#endif
}

__device__ __forceinline__ void conv_phase(Frame& F) {
    const bf16* proj = (const bf16*)(F.ws + WS0_PROJ);
    bf16* xbcp = (bf16*)((unsigned char*)F.out + DO_XBC);
    const size_t total = (size_t)M * (CONVCH / 8), stride = (size_t)F.G * NTHREADS;
    for (size_t i = (size_t)blockIdx.x * NTHREADS + F.tid; i < total; i += stride) {
        const int row = (int)(i / (CONVCH / 8)), cg = (int)(i % (CONVCH / 8)), c0 = cg * 8, t = row % SEQ;
        float acc[8];
#pragma unroll
        for (int e = 0; e < 8; ++e) acc[e] = F.conv_b[c0 + e];
#pragma unroll
        for (int j = 0; j < 5; ++j) {
            const int tt = t + j - 2;
            if (tt >= 0 && tt < SEQ) {
                const u32x4 w = *(const u32x4*)(proj + (size_t)(row + j - 2) * LDP0 + P0_XBC + c0);
                const f32x4 k0 = *(const f32x4*)(F.conv_w + j * CONVCH + c0), k1 = *(const f32x4*)(F.conv_w + j * CONVCH + c0 + 4);
                acc[0] += bflo(w.x) * k0.x; acc[1] += bfhi(w.x) * k0.y; acc[2] += bflo(w.y) * k0.z; acc[3] += bfhi(w.y) * k0.w;
                acc[4] += bflo(w.z) * k1.x; acc[5] += bfhi(w.z) * k1.y; acc[6] += bflo(w.w) * k1.z; acc[7] += bfhi(w.w) * k1.w;
            }
        }
        u32x4 o; o.x = pk2(silu_f(acc[0]), silu_f(acc[1])); o.y = pk2(silu_f(acc[2]), silu_f(acc[3])); o.z = pk2(silu_f(acc[4]), silu_f(acc[5])); o.w = pk2(silu_f(acc[6]), silu_f(acc[7]));
        *(u32x4*)(xbcp + (size_t)row * CONVCH + c0) = o;
    }
}

#if !USE_SSD_CHUNK
__device__ __forceinline__ void ssd_simple_item(Frame& F, int item) {
    const int dir = item >> 6, b = (item >> 4) & 3, h = item & 15, g = h >> 3;
    const int p = F.tid >> 3, nq = F.tid & 7;
    const float a = -__expf(F.a_log[dir * 16 + h]);
    const bf16* xbc = (const bf16*)((unsigned char*)F.out + DO_XBC);
    const float* dtv = (const float*)(F.ws + WS0_DT);
    bf16* Y; int ldy;
    if (dir == 0) { Y = (bf16*)(F.ws + WS0_PROJ) + P0_XBC; ldy = LDP0; } else { Y = (bf16*)(F.ws + WS0_XN); ldy = DM; }
    float S[16];
#pragma unroll
    for (int j = 0; j < 16; ++j) S[j] = 0.f;
    for (int tt = 0; tt < SEQ; ++tt) {
        const int tok = dir ? SEQ - 1 - tt : tt; const size_t row = (size_t)b * SEQ + tok;
        const float dt = dtv[row * 32 + dir * 16 + h];
        const float dA = __expf(dt * a);
        const float xv = bf2f(xbc[row * CONVCH + h * 64 + p]) * dt;
        const u32x4* Bp = (const u32x4*)(xbc + row * CONVCH + 1024 + g * 128 + nq * 16); const u32x4 b0 = Bp[0], b1 = Bp[1];
        const u32x4* Cp = (const u32x4*)(xbc + row * CONVCH + 1280 + g * 128 + nq * 16); const u32x4 c0 = Cp[0], c1 = Cp[1];
        const float Bv[16] = {bflo(b0.x), bfhi(b0.x), bflo(b0.y), bfhi(b0.y), bflo(b0.z), bfhi(b0.z), bflo(b0.w), bfhi(b0.w), bflo(b1.x), bfhi(b1.x), bflo(b1.y), bfhi(b1.y), bflo(b1.z), bfhi(b1.z), bflo(b1.w), bfhi(b1.w)};
        const float Cv[16] = {bflo(c0.x), bfhi(c0.x), bflo(c0.y), bfhi(c0.y), bflo(c0.z), bfhi(c0.z), bflo(c0.w), bfhi(c0.w), bflo(c1.x), bfhi(c1.x), bflo(c1.y), bfhi(c1.y), bflo(c1.z), bfhi(c1.z), bflo(c1.w), bfhi(c1.w)};
        float acc = 0.f;
#pragma unroll
        for (int j = 0; j < 16; ++j) { S[j] = dA * S[j] + xv * Bv[j]; acc += Cv[j] * S[j]; }
        acc += __shfl_xor(acc, 1); acc += __shfl_xor(acc, 2); acc += __shfl_xor(acc, 4);
        if (nq == 0) Y[row * ldy + h * 64 + p] = (bf16)f2bf(acc);
    }
}

#endif
#if !USE_NA_MFMA
__device__ __forceinline__ float dot64(const bf16* kp, const float (&q)[64]) {
    float s = 0.f;
#pragma unroll
    for (int c = 0; c < 8; ++c) { const u32x4 w = *(const u32x4*)(kp + 8 * c);
        s += q[8 * c] * bflo(w.x) + q[8 * c + 1] * bfhi(w.x) + q[8 * c + 2] * bflo(w.y) + q[8 * c + 3] * bfhi(w.y) + q[8 * c + 4] * bflo(w.z) + q[8 * c + 5] * bfhi(w.z) + q[8 * c + 6] * bflo(w.w) + q[8 * c + 7] * bfhi(w.w); }
    return s;
}
__device__ __forceinline__ void na_simple(Frame& F, int blk, int nblk) {
    bf16* proj = (bf16*)(F.ws + WS0_PROJ);
    const size_t total = (size_t)M * 16, stride = (size_t)nblk * NTHREADS;
    for (size_t i = (size_t)blk * NTHREADS + F.tid; i < total; i += stride) {
        const int row = (int)(i >> 4), h = (int)(i & 15), b = row / SEQ, t = row % SEQ, r = t >> 6, w = t & 63;
        int rs = r - 4; rs = rs < 0 ? 0 : (rs > 56 ? 56 : rs);
        int cs = w - 8; cs = cs < 0 ? 0 : (cs > 48 ? 48 : cs);
        float q[64];
        {
            const bf16* qp = proj + (size_t)row * LDP0 + P0_Q + h * 64;
#pragma unroll
            for (int c = 0; c < 8; ++c) { const u32x4 v = *(const u32x4*)(qp + 8 * c);
                q[8 * c] = bflo(v.x); q[8 * c + 1] = bfhi(v.x); q[8 * c + 2] = bflo(v.y); q[8 * c + 3] = bfhi(v.y); q[8 * c + 4] = bflo(v.z); q[8 * c + 5] = bfhi(v.z); q[8 * c + 6] = bflo(v.w); q[8 * c + 7] = bfhi(v.w); }
        }
        const float* rp = F.rpb + (size_t)h * 15 * 31;
        float mx = -1e30f;
        for (int ii = 0; ii < 8; ++ii) for (int jj = 0; jj < 16; ++jj) {
            const int kr = rs + ii, kc = cs + jj; const size_t krow = (size_t)b * SEQ + kr * 64 + kc;
            const float s = dot64(proj + krow * LDP0 + P0_K + h * 64, q) + rp[(kr - r + 7) * 31 + (kc - w + 15)];
            mx = fmaxf(mx, s);
        }
        float o[64]; float l = 0.f;
#pragma unroll
        for (int d = 0; d < 64; ++d) o[d] = 0.f;
        for (int ii = 0; ii < 8; ++ii) for (int jj = 0; jj < 16; ++jj) {
            const int kr = rs + ii, kc = cs + jj; const size_t krow = (size_t)b * SEQ + kr * 64 + kc;
            const float s = dot64(proj + krow * LDP0 + P0_K + h * 64, q) + rp[(kr - r + 7) * 31 + (kc - w + 15)];
            const float pr = __expf(s - mx); l += pr;
            const bf16* vp = proj + krow * LDP0 + P0_V + h * 64;
#pragma unroll
            for (int c = 0; c < 8; ++c) { const u32x4 v = *(const u32x4*)(vp + 8 * c);
                o[8 * c] += pr * bflo(v.x); o[8 * c + 1] += pr * bfhi(v.x); o[8 * c + 2] += pr * bflo(v.y); o[8 * c + 3] += pr * bfhi(v.y);
                o[8 * c + 4] += pr * bflo(v.z); o[8 * c + 5] += pr * bfhi(v.z); o[8 * c + 6] += pr * bflo(v.w); o[8 * c + 7] += pr * bfhi(v.w); }
        }
        const float inv = 1.f / l;
        bf16* op = proj + (size_t)row * LDP0 + P0_Q + h * 64;
#pragma unroll
        for (int c = 0; c < 8; ++c) { u32x4 v; v.x = pk2(o[8 * c] * inv, o[8 * c + 1] * inv); v.y = pk2(o[8 * c + 2] * inv, o[8 * c + 3] * inv); v.z = pk2(o[8 * c + 4] * inv, o[8 * c + 5] * inv); v.w = pk2(o[8 * c + 6] * inv, o[8 * c + 7] * inv);
            *(u32x4*)(op + 8 * c) = v; }
    }
}

#endif
__device__ __forceinline__ void gate_phase(Frame& F) {
    bf16* proj = (bf16*)(F.ws + WS0_PROJ);
    const bf16* yb = (const bf16*)(F.ws + WS0_XN);
    const bf16* xbc = (const bf16*)((unsigned char*)F.out + DO_XBC);
    const int gw = F.vcu * NWAVES + F.wave, NGW = F.G * NWAVES;
    for (int m = gw; m < M; m += NGW) {
        f32x4 v[4]; float ss = 0.f;
#pragma unroll
        for (int j = 0; j < 4; ++j) { const int c = 4 * F.lane + 256 * j;
            const u32x2 zf = *(const u32x2*)(proj + (size_t)m * LDP0 + P0_Z + c), yf = *(const u32x2*)(proj + (size_t)m * LDP0 + P0_XBC + c), ybv = *(const u32x2*)(yb + (size_t)m * DM + c), xs = *(const u32x2*)(xbc + (size_t)m * CONVCH + c);
            const float dsk = F.d_skip[c >> 6];
            f32x4 y; y.x = bflo(yf.x) + bflo(ybv.x) + dsk * bflo(xs.x); y.y = bfhi(yf.x) + bfhi(ybv.x) + dsk * bfhi(xs.x); y.z = bflo(yf.y) + bflo(ybv.y) + dsk * bflo(xs.y); y.w = bfhi(yf.y) + bfhi(ybv.y) + dsk * bfhi(xs.y);
            y.x *= silu_f(bflo(zf.x)); y.y *= silu_f(bfhi(zf.x)); y.z *= silu_f(bflo(zf.y)); y.w *= silu_f(bfhi(zf.y));
            v[j] = y; ss += (y.x * y.x + y.y * y.y) + (y.z * y.z + y.w * y.w); }
        const float rstd = rsqrtf(wave_sum(ss) * (1.f / DM) + EPS);
#pragma unroll
        for (int j = 0; j < 4; ++j) { const int c = 4 * F.lane + 256 * j; const f32x4 g = *(const f32x4*)(F.ssd_norm + c); const f32x4 o = v[j] * rstd * g;
            u32x2 w; w.x = pk2(o.x, o.y); w.y = pk2(o.z, o.w); *(u32x2*)(proj + (size_t)m * LDP0 + P0_Z + c) = w; }
    }
}

#if !USE_MLSTM_CHUNK
__device__ __forceinline__ void mlstm_simple_item(Frame& F, int item, int dir) {
    const int b = item >> 3, h = item & 7;
    const int v = F.tid & 255, kh = F.tid >> 8;
    const bf16* proj = (const bf16*)(F.ws + WS1_PROJ);
    const float* gates = (const float*)(F.ws + WS1_GATES);
    bf16* H = (bf16*)(F.ws + WS1_H);
    LAS float* qs = (LAS float*)F.lds;
    LAS float* red = qs + 256;
    float C[64], nn[64];
#pragma unroll
    for (int j = 0; j < 64; ++j) { C[j] = 0.f; nn[j] = 0.f; }
    for (int tt = 0; tt < SEQ; ++tt) {
        const int tok = dir ? SEQ - 1 - tt : tt; const size_t row = (size_t)b * SEQ + tok;
        if (F.tid < 256) { const int which = F.tid >> 7, kk = F.tid & 127; qs[F.tid] = bf2f(proj[row * LDP1 + (which ? P1_K : P1_Q) + h * 128 + kk]); }
        const float ig = gates[row * 32 + (dir * 2 + 0) * 8 + h], fg = gates[row * 32 + (dir * 2 + 1) * 8 + h];
        const float fs = sigmoid_f(fg), ie = __expf(ig);
        const float vv = bf2f(proj[row * LDP1 + P1_V + h * 256 + v]);
        __syncthreads();
        float num = 0.f, den = 0.f;
#pragma unroll
        for (int j = 0; j < 64; ++j) { const float kq = qs[kh * 64 + j], kk = qs[128 + kh * 64 + j];
            C[j] = fs * C[j] + (ie * kk) * vv; nn[j] = fs * nn[j] + ie * kk; num += kq * C[j]; den += kq * nn[j]; }
        red[kh * 256 + v] = num; if (v == 0) red[512 + kh] = den;
        __syncthreads();
        if (kh == 0) {
            const float nt = red[v] + red[256 + v], dn = red[512] + red[513];
            float hv = nt / fmaxf(fabsf(dn), 1.f);
            bf16* hp = H + row * 2048 + h * 256 + v;
            if (dir) hv += bf2f(*hp);
            *hp = (bf16)f2bf(hv);
        }
    }
}
#endif
typedef short s16x4 __attribute__((ext_vector_type(4)));
typedef float f32x16 __attribute__((ext_vector_type(16)));
typedef float f32x2 __attribute__((ext_vector_type(2)));
__device__ __forceinline__ s16x4 lds_tr(LAS const unsigned char* p) { return __builtin_bit_cast(s16x4, __builtin_amdgcn_ds_read_tr16_b64_v4i16((LAS s16x4*)p)); }
__device__ __forceinline__ bf16x8 tr8(LAS const unsigned char* p0, LAS const unsigned char* p1) { const s16x4 a = lds_tr(p0), b = lds_tr(p1); return (bf16x8){a.x, a.y, a.z, a.w, b.x, b.y, b.z, b.w}; }
#define MFMA32(a, b, c) __builtin_amdgcn_mfma_f32_32x32x16_bf16((a), (b), (c), 0, 0, 0)
namespace ck {
constexpr int SQ = 272, SV = 80;
constexpr int L_Q = 0, L_K = L_Q + 128 * SQ, L_P = L_K + 128 * SQ, L_V = L_P + 128 * SQ, L_VW = L_V + 128 * SV, L_CT = L_VW + 128 * SV, L_VEC = L_CT + 2 * 32 * SQ;
constexpr int VEC_BYTES = 3072;
constexpr int V_U2 = 0, V_Z2 = 512, V_ISC = 1024, V_DN = 1536, V_W = 2048, V_WROW = 2560, V_SCAL = 2816;
constexpr int L_DENP = L_VEC + 2 * VEC_BYTES, L_NROW = L_DENP + 1024, L_ZERO = L_NROW + 512, L_END = L_ZERO + 512;
constexpr float LOG2E = 1.4426950408889634f;
}
static_assert(ck::L_END <= LDS_BYTES - 64, "chunk-scan LDS map");
__device__ __forceinline__ float logsig_f(float x) { return fminf(x, 0.f) - log1pf(__expf(-fabsf(x))); }

__device__ __forceinline__ float wave_incl_sum(float v, int lane) {
#pragma unroll
    for (int o = 1; o < 64; o <<= 1) { const float t = __shfl_up(v, o); if (lane >= o) v += t; }
    return v;
}
__device__ __forceinline__ float wave_incl_max(float v, int lane) {
#pragma unroll
    for (int o = 1; o < 64; o <<= 1) { const float t = __shfl_up(v, o); if (lane >= o) v = fmaxf(v, t); }
    return v;
}
__device__ __forceinline__ void mlstm_prescan(Frame& F, int ch0, int nch) {
    const float* gates = (const float*)(F.ws + WS1_GATES);
    float* gvb = (float*)(F.ws + WS1_GV); float* gvz = gvb + (size_t)2 * M * 8; float* gvp = gvz + (size_t)2 * M * 8;
    const int lane = F.lane;
    for (int task = F.wave; task < nch * 16; task += NWAVES) {
        const int ch = ch0 + (task >> 4), dir = (task >> 3) & 1, h = task & 7;
        const int r0 = dir ? (ch * 128 + 127 - 2 * lane) : (ch * 128 + 2 * lane), r1 = dir ? r0 - 1 : r0 + 1;
        const float i0 = gates[(size_t)r0 * 32 + (dir * 2) * 8 + h], f0 = gates[(size_t)r0 * 32 + (dir * 2 + 1) * 8 + h];
        const float i1 = gates[(size_t)r1 * 32 + (dir * 2) * 8 + h], f1 = gates[(size_t)r1 * 32 + (dir * 2 + 1) * 8 + h];
        const float lf0 = logsig_f(f0), lf1 = logsig_f(f1), ps = lf0 + lf1;
        const float sc = wave_incl_sum(ps, lane);
        const float b0 = (sc - ps) + lf0, b1 = b0 + lf1, z0 = i0 - b0, z1 = i1 - b1, pm = fmaxf(z0, z1);
        const float sm = wave_incl_max(pm, lane);
        float exm = __shfl_up(sm, 1); if (lane == 0) exm = -3.0e38f;
        const size_t o0 = ((size_t)dir * M + r0) * 8 + h, o1 = ((size_t)dir * M + r1) * 8 + h;
        gvb[o0] = b0; gvb[o1] = b1; gvz[o0] = z0; gvz[o1] = z1; gvp[o0] = fmaxf(exm, z0); gvp[o1] = fmaxf(exm, pm);
    }
}
__device__ __forceinline__ void ssd_prescan(Frame& F) {
    const float* dtp = (const float*)(F.ws + WS0_DT); float* cs = (float*)(F.ws + WS0_CS);
    const int lane = F.lane, gw = F.vcu * NWAVES + F.wave, NGW = F.G * NWAVES;
    for (int task = gw; task < (M / 128) * 32; task += NGW) {
        const int ch = task >> 5, dh = task & 31, dir = dh >> 4;
        const int r0 = dir ? (ch * 128 + 127 - 2 * lane) : (ch * 128 + 2 * lane), r1 = dir ? r0 - 1 : r0 + 1;
        const float a_h = -__expf(F.a_log[dh]);
        const float a0 = dtp[(size_t)r0 * 32 + dh] * a_h, a1 = dtp[(size_t)r1 * 32 + dh] * a_h, ps = a0 + a1;
        const float sc = wave_incl_sum(ps, lane);
        const float c0 = (sc - ps) + a0;
        cs[(size_t)r0 * 32 + dh] = c0; cs[(size_t)r1 * 32 + dh] = c0 + a1;
    }
}

__device__ __forceinline__ void mlstm_chunk_item(Frame& F, int item, int dir) {
    using namespace ck;
    const int b = item >> 6, h = (item >> 3) & 7, sl = item & 7;
    const int tid = F.tid, lane = F.lane, w = F.wave, l31 = lane & 31, hh = lane >> 5;
    const int blk = (lane >> 4) & 1, tq = (lane & 15) >> 2, tp = lane & 3;
    LAS unsigned char* lds = F.lds;
    const bf16* proj = (const bf16*)(F.ws + WS1_PROJ);
    const float* gvb = (const float*)(F.ws + WS1_GV) + ((size_t)dir * M) * 8 + h; const float* gvz = gvb + (size_t)2 * M * 8; const float* gvp = gvz + (size_t)2 * M * 8;
    bf16* H = (bf16*)(F.ws + WS1_H);
    const size_t rowbase = (size_t)b * SEQ;
#define TOK(c, r) (dir ? (SEQ - 1 - ((c) * 128 + (r))) : ((c) * 128 + (r)))
    u32x4 rq[4], rk[4], rv; float gb0 = 0.f, gb1 = 0.f, gz0 = 0.f, gz1 = 0.f, gp0 = 0.f, gp1 = 0.f;
#define CK_LOAD(c) do { \
        _Pragma("unroll") for (int j = 0; j < 4; ++j) { const int pid = tid + 512 * j, r = pid >> 4, ch = pid & 15; const bf16* rp = proj + (rowbase + TOK(c, r)) * LDP1 + h * 128 + 8 * ch; \
            rq[j] = *(const u32x4*)(rp + P1_Q); rk[j] = *(const u32x4*)(rp + P1_K); } \
        { const int r = tid >> 2, ch = tid & 3; rv = *(const u32x4*)(proj + (rowbase + TOK(c, r)) * LDP1 + P1_V + h * 256 + sl * 32 + 8 * ch); } \
        } while (0)
#define CK_GLOAD(c) do { if (w == 4) { const size_t g0 = (rowbase + TOK(c, 2 * lane)) * 8, g1 = (rowbase + TOK(c, 2 * lane + 1)) * 8; \
            gb0 = gvb[g0]; gb1 = gvb[g1]; gz0 = gvz[g0]; gz1 = gvz[g1]; gp0 = gvp[g0]; gp1 = gvp[g1]; } } while (0)
    float m_prev = 0.f;
#define CK_GATES(nb) do { \
        LAS unsigned char* vb = lds + L_VEC + (nb) * VEC_BYTES; \
        const float gtot = __shfl(gb1, 63), zmax = __shfl(gp1, 63); \
        const float u0 = -fmaxf(m_prev, gp0), u1 = -fmaxf(m_prev, gp1); \
        *(LAS f32x2*)(vb + V_U2 + 8 * lane) = (f32x2){u0 * LOG2E, u1 * LOG2E}; \
        *(LAS f32x2*)(vb + V_Z2 + 8 * lane) = (f32x2){gz0 * LOG2E, gz1 * LOG2E}; \
        *(LAS f32x2*)(vb + V_ISC + 8 * lane) = (f32x2){__expf(m_prev + u0), __expf(m_prev + u1)}; \
        *(LAS f32x2*)(vb + V_DN + 8 * lane) = (f32x2){__expf(u0 - gb0), __expf(u1 - gb1)}; \
        const float w0 = __expf(gz0 - zmax), w1 = __expf(gz1 - zmax); \
        *(LAS f32x2*)(vb + V_W + 8 * lane) = (f32x2){w0, w1}; \
        *(LAS unsigned*)(vb + V_WROW + 4 * lane) = pk2(w0, w1); \
        const float Mx = fmaxf(m_prev, zmax); \
        if (lane == 0) *(LAS f32x2*)(vb + V_SCAL) = (f32x2){__expf(m_prev - Mx), __expf(zmax - Mx)}; \
        m_prev = gtot + Mx; } while (0)
#define CK_WRITE(nb) do { \
        _Pragma("unroll") for (int j = 0; j < 4; ++j) { const int pid = tid + 512 * j, r = pid >> 4, ch = pid & 15; \
            *(LAS u32x4*)(lds + L_Q + r * SQ + ch * 16) = rq[j]; *(LAS u32x4*)(lds + L_K + r * SQ + ch * 16) = rk[j]; } \
        { const int r = tid >> 2, ch = tid & 3; *(LAS u32x4*)(lds + L_V + r * SV + ch * 16) = rv; \
          const float wv = *(LAS float*)(lds + L_VEC + (nb) * VEC_BYTES + V_W + 4 * r); u32x4 o; \
          o.x = pk2(bflo(rv.x) * wv, bfhi(rv.x) * wv); o.y = pk2(bflo(rv.y) * wv, bfhi(rv.y) * wv); o.z = pk2(bflo(rv.z) * wv, bfhi(rv.z) * wv); o.w = pk2(bflo(rv.w) * wv, bfhi(rv.w) * wv); \
          *(LAS u32x4*)(lds + L_VW + r * SV + ch * 16) = o; } } while (0)

    __syncthreads();
    for (int i = tid; i < (2 * 32 * SQ) / 4; i += NTHREADS) ((LAS unsigned*)(lds + L_CT))[i] = 0u;
    for (int i = tid; i < (512 + 512) / 4; i += NTHREADS) ((LAS unsigned*)(lds + L_NROW))[i] = 0u;
    f32x16 Cst; float nst = 0.f;
#pragma unroll
    for (int i = 0; i < 16; ++i) Cst[i] = 0.f;
    CK_LOAD(0);
    CK_GLOAD(0);
    if (w == 4) CK_GATES(0);
    CK_GLOAD(1);
    __syncthreads();
    CK_WRITE(0);
    __syncthreads();

    for (int c = 0; c < SEQ / 128; ++c) {
        const int cur = c & 1, nxt = cur ^ 1;
        const bool more = (c + 1 < SEQ / 128);
        unsigned long long pt0 = 0, pt1 = 0, pt2 = 0; if (PROBE_SUB) pt0 = __builtin_amdgcn_s_memrealtime();
        if (w == 4 && more) CK_GATES(nxt);
        if (more) CK_LOAD(c + 1);
        if (c + 2 < SEQ / 128) CK_GLOAD(c + 2);
        LAS unsigned char* vc = lds + L_VEC + cur * VEC_BYTES;
        {
            const int tb = w & 3, sbp = w >> 2, t = 32 * tb + l31;
            const float ut = *(LAS float*)(vc + V_U2 + 4 * t);
            float rs = 0.f;
            if (2 * sbp <= tb) {
                bf16x8 qf[8];
#pragma unroll
                for (int ks = 0; ks < 8; ++ks) qf[ks] = *(LAS bf16x8*)(lds + L_Q + t * SQ + (16 * ks + 8 * hh) * 2);
#pragma unroll 1
                for (int sbi = 0; sbi < 2; ++sbi) {
                    const int sb = 2 * sbp + sbi;
                    if (sb <= tb) {
                        f32x16 acc;
#pragma unroll
                        for (int i = 0; i < 16; ++i) acc[i] = 0.f;
#pragma unroll
                        for (int ks = 0; ks < 8; ++ks) { const bf16x8 kf = *(LAS bf16x8*)(lds + L_K + (32 * sb + l31) * SQ + (16 * ks + 8 * hh) * 2); acc = MFMA32(kf, qf[ks], acc); }
#pragma unroll
                        for (int g = 0; g < 4; ++g) {
                            const int s0 = 32 * sb + 8 * g + 4 * hh;
                            const f32x4 zz = *(LAS f32x4*)(vc + V_Z2 + 4 * s0);
                            float pv[4];
#pragma unroll
                            for (int e = 0; e < 4; ++e) { float v = acc[4 * g + e] * __builtin_amdgcn_exp2f(ut + zz[e]); v = (s0 + e > t) ? 0.f : v; rs += v; pv[e] = v; }
                            u32x2 o; o.x = pk2(pv[0], pv[1]); o.y = pk2(pv[2], pv[3]);
                            *(LAS u32x2*)(lds + L_P + t * SQ + s0 * 2) = o;
                        }
                    }
                }
            }
            rs += __shfl_xor(rs, 32);
            if (hh == 0) *(LAS float*)(lds + L_DENP + (sbp * 128 + t) * 4) = rs;
        }
        __syncthreads();
        if (PROBE_SUB) pt1 = __builtin_amdgcn_s_memrealtime();
        if (w < 4) {
            const int tb = w, t = 32 * tb + l31;
            bf16* hp = H + (rowbase + TOK(c, t)) * 2048 + h * 256 + sl * 32 + 4 * hh;
            u32x2 hold[4];
            if (dir) {
#pragma unroll
                for (int g = 0; g < 4; ++g) hold[g] = *(const u32x2*)(hp + 8 * g);
            }
            f32x16 ai, ae, an;
#pragma unroll
            for (int i = 0; i < 16; ++i) { ai[i] = 0.f; ae[i] = 0.f; an[i] = 0.f; }
#define CK_INTRA(NKS) do { _Pragma("unroll") for (int ks = 0; ks < (NKS); ++ks) { \
                LAS const unsigned char* va = lds + L_V + (16 * ks + 8 * hh + tq) * SV + (16 * blk + 4 * tp) * 2; \
                const bf16x8 a = tr8(va, va + 4 * SV); \
                const bf16x8 bb = *(LAS bf16x8*)(lds + L_P + t * SQ + (16 * ks + 8 * hh) * 2); \
                ai = MFMA32(a, bb, ai); } } while (0)
            if (tb == 0) CK_INTRA(2); else if (tb == 1) CK_INTRA(4); else if (tb == 2) CK_INTRA(6); else CK_INTRA(8);
#undef CK_INTRA
            LAS const unsigned char* nrp = (l31 == 0) ? (lds + L_NROW + cur * 256) : (lds + L_ZERO);
#pragma unroll
            for (int ks = 0; ks < 8; ++ks) {
                const bf16x8 qf = *(LAS bf16x8*)(lds + L_Q + t * SQ + (16 * ks + 8 * hh) * 2);
                const bf16x8 a = *(LAS bf16x8*)(lds + L_CT + cur * 32 * SQ + l31 * SQ + (16 * ks + 8 * hh) * 2);
                ae = MFMA32(a, qf, ae);
                const bf16x8 nf = *(LAS bf16x8*)(nrp + (16 * ks + 8 * hh) * 2);
                an = MFMA32(nf, qf, an);
            }
            const float isc = *(LAS float*)(vc + V_ISC + 4 * t), dnt = *(LAS float*)(vc + V_DN + 4 * t);
            const float qn = __shfl(an[0], l31);
            const float den = *(LAS float*)(lds + L_DENP + t * 4) + *(LAS float*)(lds + L_DENP + (128 + t) * 4) + isc * qn;
            const float inv = 1.f / fmaxf(fabsf(den), dnt);
#pragma unroll
            for (int g = 0; g < 4; ++g) {
                float hv[4];
#pragma unroll
                for (int e = 0; e < 4; ++e) hv[e] = (ai[4 * g + e] + isc * ae[4 * g + e]) * inv;
                if (dir) { hv[0] += bflo(hold[g].x); hv[1] += bfhi(hold[g].x); hv[2] += bflo(hold[g].y); hv[3] += bfhi(hold[g].y); }
                u32x2 o; o.x = pk2(hv[0], hv[1]); o.y = pk2(hv[2], hv[3]);
                *(u32x2*)(hp + 8 * g) = o;
            }
        } else {
            const int kb = w - 4;
            f32x16 dC, dnn;
#pragma unroll
            for (int i = 0; i < 16; ++i) { dC[i] = 0.f; dnn[i] = 0.f; }
            LAS const unsigned char* wrp = (l31 == 0) ? (vc + V_WROW) : (lds + L_ZERO);
#pragma unroll
            for (int ks = 0; ks < 8; ++ks) {
                LAS const unsigned char* ka = lds + L_K + (16 * ks + 8 * hh + tq) * SQ + (32 * kb + 16 * blk + 4 * tp) * 2;
                const bf16x8 kf = tr8(ka, ka + 4 * SQ);
                LAS const unsigned char* va = lds + L_VW + (16 * ks + 8 * hh + tq) * SV + (16 * blk + 4 * tp) * 2;
                const bf16x8 vf = tr8(va, va + 4 * SV);
                dC = MFMA32(kf, vf, dC);
                const bf16x8 wf = *(LAS bf16x8*)(wrp + (16 * ks + 8 * hh) * 2);
                dnn = MFMA32(wf, kf, dnn);
            }
            const f32x2 ss = *(LAS f32x2*)(vc + V_SCAL);
#pragma unroll
            for (int i = 0; i < 16; ++i) Cst[i] = ss.x * Cst[i] + ss.y * dC[i];
#pragma unroll
            for (int g = 0; g < 4; ++g) { u32x2 o; o.x = pk2(Cst[4 * g], Cst[4 * g + 1]); o.y = pk2(Cst[4 * g + 2], Cst[4 * g + 3]);
                *(LAS u32x2*)(lds + L_CT + nxt * 32 * SQ + l31 * SQ + (32 * kb + 8 * g + 4 * hh) * 2) = o; }
            nst = ss.x * nst + ss.y * dnn[0];
            if (hh == 0) *(LAS bf16*)(lds + L_NROW + nxt * 256 + (32 * kb + l31) * 2) = (bf16)f2bf(nst);
        }
        __syncthreads();
        if (PROBE_SUB) pt2 = __builtin_amdgcn_s_memrealtime();
        if (more) CK_WRITE(nxt);
        __syncthreads();
        if (PROBE_SUB >= 1 && PROBE_SUB <= 3) { const unsigned long long pt3 = __builtin_amdgcn_s_memrealtime(); F.tacc += (PROBE_SUB == 1) ? pt1 - pt0 : (PROBE_SUB == 2) ? pt2 - pt1 : pt3 - pt2; }
    }
#undef TOK
#undef CK_LOAD
#undef CK_GATES
#undef CK_GLOAD
#undef CK_WRITE
}

__device__ __forceinline__ void ssd_chunk_item(Frame& F, int item) {
    using namespace ck;
    const int dir = item >> 7, b = (item >> 5) & 3, h = (item >> 1) & 15, ph = item & 1, gq = h >> 3;
    const int tid = F.tid, lane = F.lane, w = F.wave, l31 = lane & 31, hh = lane >> 5;
    const int blk = (lane >> 4) & 1, tq = (lane & 15) >> 2, tp = lane & 3;
    LAS unsigned char* lds = F.lds;
    const bf16* xbc = (const bf16*)((unsigned char*)F.out + DO_XBC);
    const float* dtp = (const float*)(F.ws + WS0_DT); const float* csp = (const float*)(F.ws + WS0_CS);
    bf16* Y; int ldy;
    if (dir == 0) { Y = (bf16*)(F.ws + WS0_PROJ) + P0_XBC; ldy = LDP0; } else { Y = (bf16*)(F.ws + WS0_XN); ldy = DM; }
    const size_t rowbase = (size_t)b * SEQ;
#define TOK(c, r) (dir ? (SEQ - 1 - ((c) * 128 + (r))) : ((c) * 128 + (r)))
    u32x4 rq[4], rk[4], rv; float d0 = 0.f, d1 = 0.f, cs0 = 0.f, cs1 = 0.f;
#define SK_LOAD(c) do { \
        _Pragma("unroll") for (int j = 0; j < 4; ++j) { const int pid = tid + 512 * j, r = pid >> 4, ch = pid & 15; const bf16* rp = xbc + (rowbase + TOK(c, r)) * CONVCH + gq * 128 + 8 * ch; \
            rq[j] = *(const u32x4*)(rp + 1280); rk[j] = *(const u32x4*)(rp + 1024); } \
        { const int r = tid >> 2, ch = tid & 3; rv = *(const u32x4*)(xbc + (rowbase + TOK(c, r)) * CONVCH + h * 64 + ph * 32 + 8 * ch); } \
        } while (0)
#define SK_GLOAD(c) do { if (w == 4) { const size_t g0 = (rowbase + TOK(c, 2 * lane)) * 32 + dir * 16 + h, g1 = (rowbase + TOK(c, 2 * lane + 1)) * 32 + dir * 16 + h; d0 = dtp[g0]; d1 = dtp[g1]; cs0 = csp[g0]; cs1 = csp[g1]; } } while (0)
#define SK_GATES(nb) do { \
        LAS unsigned char* vb = lds + L_VEC + (nb) * VEC_BYTES; \
        const float tot = __shfl(cs1, 63); \
        *(LAS f32x2*)(vb + V_U2 + 8 * lane) = (f32x2){cs0 * LOG2E, cs1 * LOG2E}; \
        *(LAS f32x2*)(vb + V_Z2 + 8 * lane) = (f32x2){-cs0 * LOG2E, -cs1 * LOG2E}; \
        *(LAS f32x2*)(vb + V_ISC + 8 * lane) = (f32x2){__expf(cs0), __expf(cs1)}; \
        *(LAS f32x2*)(vb + V_DN + 8 * lane) = (f32x2){d0, d1}; \
        *(LAS f32x2*)(vb + V_W + 8 * lane) = (f32x2){__expf(tot - cs0), __expf(tot - cs1)}; \
        if (lane == 0) *(LAS f32x2*)(vb + V_SCAL) = (f32x2){__expf(tot), 1.f}; } while (0)
#define SK_WRITE(nb) do { \
        _Pragma("unroll") for (int j = 0; j < 4; ++j) { const int pid = tid + 512 * j, r = pid >> 4, ch = pid & 15; \
            *(LAS u32x4*)(lds + L_Q + r * SQ + ch * 16) = rq[j]; *(LAS u32x4*)(lds + L_K + r * SQ + ch * 16) = rk[j]; } \
        { const int r = tid >> 2, ch = tid & 3; \
          const float dv = *(LAS float*)(lds + L_VEC + (nb) * VEC_BYTES + V_DN + 4 * r), wv = dv * *(LAS float*)(lds + L_VEC + (nb) * VEC_BYTES + V_W + 4 * r); u32x4 o; \
          o.x = pk2(bflo(rv.x) * dv, bfhi(rv.x) * dv); o.y = pk2(bflo(rv.y) * dv, bfhi(rv.y) * dv); o.z = pk2(bflo(rv.z) * dv, bfhi(rv.z) * dv); o.w = pk2(bflo(rv.w) * dv, bfhi(rv.w) * dv); \
          *(LAS u32x4*)(lds + L_V + r * SV + ch * 16) = o; \
          o.x = pk2(bflo(rv.x) * wv, bfhi(rv.x) * wv); o.y = pk2(bflo(rv.y) * wv, bfhi(rv.y) * wv); o.z = pk2(bflo(rv.z) * wv, bfhi(rv.z) * wv); o.w = pk2(bflo(rv.w) * wv, bfhi(rv.w) * wv); \
          *(LAS u32x4*)(lds + L_VW + r * SV + ch * 16) = o; } } while (0)

    __syncthreads();
    for (int i = tid; i < (2 * 32 * SQ) / 4; i += NTHREADS) ((LAS unsigned*)(lds + L_CT))[i] = 0u;
    f32x16 Sst;
#pragma unroll
    for (int i = 0; i < 16; ++i) Sst[i] = 0.f;
    SK_LOAD(0);
    SK_GLOAD(0);
    if (w == 4) SK_GATES(0);
    SK_GLOAD(1);
    __syncthreads();
    SK_WRITE(0);
    __syncthreads();

    for (int c = 0; c < SEQ / 128; ++c) {
        const int cur = c & 1, nxt = cur ^ 1;
        const bool more = (c + 1 < SEQ / 128);
        if (w == 4 && more) SK_GATES(nxt);
        if (more) SK_LOAD(c + 1);
        if (c + 2 < SEQ / 128) SK_GLOAD(c + 2);
        LAS unsigned char* vc = lds + L_VEC + cur * VEC_BYTES;
        {
            const int tb = w & 3, sbp = w >> 2, t = 32 * tb + l31;
            const float ut = *(LAS float*)(vc + V_U2 + 4 * t);
            if (2 * sbp <= tb) {
                bf16x8 qf[8];
#pragma unroll
                for (int ks = 0; ks < 8; ++ks) qf[ks] = *(LAS bf16x8*)(lds + L_Q + t * SQ + (16 * ks + 8 * hh) * 2);
#pragma unroll 1
                for (int sbi = 0; sbi < 2; ++sbi) {
                    const int sb = 2 * sbp + sbi;
                    if (sb <= tb) {
                        f32x16 acc;
#pragma unroll
                        for (int i = 0; i < 16; ++i) acc[i] = 0.f;
#pragma unroll
                        for (int ks = 0; ks < 8; ++ks) { const bf16x8 kf = *(LAS bf16x8*)(lds + L_K + (32 * sb + l31) * SQ + (16 * ks + 8 * hh) * 2); acc = MFMA32(kf, qf[ks], acc); }
#pragma unroll
                        for (int g = 0; g < 4; ++g) {
                            const int s0 = 32 * sb + 8 * g + 4 * hh;
                            const f32x4 zz = *(LAS f32x4*)(vc + V_Z2 + 4 * s0);
                            float pv[4];
#pragma unroll
                            for (int e = 0; e < 4; ++e) { float v = acc[4 * g + e] * __builtin_amdgcn_exp2f(ut + zz[e]); pv[e] = (s0 + e > t) ? 0.f : v; }
                            u32x2 o; o.x = pk2(pv[0], pv[1]); o.y = pk2(pv[2], pv[3]);
                            *(LAS u32x2*)(lds + L_P + t * SQ + s0 * 2) = o;
                        }
                    }
                }
            }
        }
        __syncthreads();
        if (w < 4) {
            const int tb = w, t = 32 * tb + l31;
            bf16* yp = Y + (rowbase + TOK(c, t)) * ldy + h * 64 + ph * 32 + 4 * hh;
            f32x16 ai, ae;
#pragma unroll
            for (int i = 0; i < 16; ++i) { ai[i] = 0.f; ae[i] = 0.f; }
#define SK_INTRA(NKS) do { _Pragma("unroll") for (int ks = 0; ks < (NKS); ++ks) { \
                LAS const unsigned char* va = lds + L_V + (16 * ks + 8 * hh + tq) * SV + (16 * blk + 4 * tp) * 2; \
                const bf16x8 a = tr8(va, va + 4 * SV); \
                const bf16x8 bb = *(LAS bf16x8*)(lds + L_P + t * SQ + (16 * ks + 8 * hh) * 2); \
                ai = MFMA32(a, bb, ai); } } while (0)
            if (tb == 0) SK_INTRA(2); else if (tb == 1) SK_INTRA(4); else if (tb == 2) SK_INTRA(6); else SK_INTRA(8);
#undef SK_INTRA
#pragma unroll
            for (int ks = 0; ks < 8; ++ks) {
                const bf16x8 qf = *(LAS bf16x8*)(lds + L_Q + t * SQ + (16 * ks + 8 * hh) * 2);
                const bf16x8 a = *(LAS bf16x8*)(lds + L_CT + cur * 32 * SQ + l31 * SQ + (16 * ks + 8 * hh) * 2);
                ae = MFMA32(a, qf, ae);
            }
            const float isc = *(LAS float*)(vc + V_ISC + 4 * t);
#pragma unroll
            for (int g = 0; g < 4; ++g) {
                u32x2 o; o.x = pk2(ai[4 * g] + isc * ae[4 * g], ai[4 * g + 1] + isc * ae[4 * g + 1]); o.y = pk2(ai[4 * g + 2] + isc * ae[4 * g + 2], ai[4 * g + 3] + isc * ae[4 * g + 3]);
                *(u32x2*)(yp + 8 * g) = o;
            }
        } else {
            const int kb = w - 4;
            f32x16 dS;
#pragma unroll
            for (int i = 0; i < 16; ++i) dS[i] = 0.f;
#pragma unroll
            for (int ks = 0; ks < 8; ++ks) {
                LAS const unsigned char* ka = lds + L_K + (16 * ks + 8 * hh + tq) * SQ + (32 * kb + 16 * blk + 4 * tp) * 2;
                const bf16x8 kf = tr8(ka, ka + 4 * SQ);
                LAS const unsigned char* va = lds + L_VW + (16 * ks + 8 * hh + tq) * SV + (16 * blk + 4 * tp) * 2;
                const bf16x8 vf = tr8(va, va + 4 * SV);
                dS = MFMA32(kf, vf, dS);
            }
            const f32x2 ss = *(LAS f32x2*)(vc + V_SCAL);
#pragma unroll
            for (int i = 0; i < 16; ++i) Sst[i] = ss.x * Sst[i] + dS[i];
#pragma unroll
            for (int g = 0; g < 4; ++g) { u32x2 o; o.x = pk2(Sst[4 * g], Sst[4 * g + 1]); o.y = pk2(Sst[4 * g + 2], Sst[4 * g + 3]);
                *(LAS u32x2*)(lds + L_CT + nxt * 32 * SQ + l31 * SQ + (32 * kb + 8 * g + 4 * hh) * 2) = o; }
        }
        __syncthreads();
        if (more) SK_WRITE(nxt);
        __syncthreads();
    }
#undef TOK
#undef SK_LOAD
#undef SK_GATES
#undef SK_GLOAD
#undef SK_WRITE
}

#define MFMA16(a, b, c) __builtin_amdgcn_mfma_f32_16x16x32_bf16((a), (b), (c), 0, 0, 0)
namespace na {
constexpr int SVN = 144, HS = 512 * SVN, L_RPB = 2 * HS, L_END = L_RPB + 2 * 465 * 4;
}
static_assert(na::L_END <= LDS_BYTES - 64, "NA LDS map");
__device__ __forceinline__ void na_mfma_item(Frame& F, int item) {
    using namespace na;
    const int b = item >> 6, hp = (item >> 3) & 7, r0 = (item & 7) * 8;
    const int tid = F.tid, lane = F.lane, w = F.wave, fr = lane & 15, fg = lane >> 4, tq = fr >> 2, tp = fr & 3;
    const int hsel = w >> 2, qb = w & 3, h = 2 * hp + hsel;
    LAS unsigned char* lds = F.lds;
    bf16* proj = (bf16*)(F.ws + WS0_PROJ);
    const size_t rowbase = (size_t)b * SEQ;
    __syncthreads();
    for (int i = tid; i < 2 * 465; i += NTHREADS) *(LAS float*)(lds + L_RPB + 4 * i) = F.rpb[(size_t)(2 * hp) * 465 + i];
    int rs = r0 - 4; rs = rs < 0 ? 0 : (rs > 56 ? 56 : rs);
#pragma unroll 4
    for (int j = 0; j < 16; ++j) { const int pid = tid + 512 * j, ch = pid & 7, hs = (pid >> 3) & 1, c = (pid >> 4) & 63, i = pid >> 10, kr = rs + i;
        const u32x4 v = *(const u32x4*)(proj + (rowbase + kr * 64 + c) * LDP0 + P0_V + (2 * hp + hs) * 64 + 8 * ch);
        *(LAS u32x4*)(lds + hs * HS + ((kr & 7) * 64 + c) * SVN + ch * 16) = v; }
    __syncthreads();
    const int kb0 = qb < 1 ? 0 : (qb > 2 ? 1 : qb - 1);
    const int wq = 16 * qb + fr;
    int cs = wq - 8; cs = cs < 0 ? 0 : (cs > 48 ? 48 : cs);
    const LAS float* rp = (const LAS float*)(lds + L_RPB + hsel * 465 * 4);
    for (int r = r0; r < r0 + 8; ++r) {
        int rsn = r + 1 - 4; rsn = rsn < 0 ? 0 : (rsn > 56 ? 56 : rsn);
        const bool slide = (r + 1 < r0 + 8) && (rsn != rs);
        u32x4 nv[2];
        if (slide) {
#pragma unroll
            for (int j = 0; j < 2; ++j) { const int pid = tid + 512 * j, ch = pid & 7, hs = (pid >> 3) & 1, c = (pid >> 4) & 63;
                nv[j] = *(const u32x4*)(proj + (rowbase + (rsn + 7) * 64 + c) * LDP0 + P0_V + (2 * hp + hs) * 64 + 8 * ch); }
        }
        bf16* qp = proj + (rowbase + r * 64 + wq) * LDP0 + P0_Q + h * 64;
        const bf16x8 q0 = *(const bf16x8*)(qp + 8 * fg), q1 = *(const bf16x8*)(qp + 32 + 8 * fg);
        f32x4 S[24];
#pragma unroll
        for (int i = 0; i < 8; ++i)
#pragma unroll
            for (int kb = 0; kb < 3; ++kb) {
                const bf16* kp = proj + (rowbase + (rs + i) * 64 + 16 * (kb0 + kb) + fr) * LDP0 + P0_K + h * 64 + 8 * fg;
                const bf16x8 k0 = *(const bf16x8*)kp, k1 = *(const bf16x8*)(kp + 32);
                f32x4 a = (f32x4){0.f, 0.f, 0.f, 0.f};
                a = MFMA16(k0, q0, a); a = MFMA16(k1, q1, a);
                S[i * 3 + kb] = a;
            }
        float mx = -3.0e38f;
#pragma unroll
        for (int i = 0; i < 8; ++i)
#pragma unroll
            for (int kb = 0; kb < 3; ++kb)
#pragma unroll
                for (int e = 0; e < 4; ++e) {
                    const int kc = 16 * (kb0 + kb) + 4 * fg + e;
                    const bool valid = (kc >= cs) && (kc < cs + 16);
                    const int bi = (rs + i - r + 7) * 31 + (valid ? (kc - wq + 15) : 0);
                    const float s = valid ? S[i * 3 + kb][e] + rp[bi] : -3.0e38f;
                    S[i * 3 + kb][e] = s; mx = fmaxf(mx, s);
                }
        mx = fmaxf(mx, __shfl_xor(mx, 16)); mx = fmaxf(mx, __shfl_xor(mx, 32));
        float l = 0.f;
#pragma unroll
        for (int t = 0; t < 24; ++t)
#pragma unroll
            for (int e = 0; e < 4; ++e) { const float p = __expf(S[t][e] - mx); S[t][e] = p; l += p; }
        l += __shfl_xor(l, 16); l += __shfl_xor(l, 32);
        f32x4 o[4];
#pragma unroll
        for (int db = 0; db < 4; ++db) o[db] = (f32x4){0.f, 0.f, 0.f, 0.f};
#pragma unroll
        for (int u = 0; u < 12; ++u) {
            const int t0 = 2 * u, t1 = 2 * u + 1, i0 = t0 / 3, k0b = t0 % 3, i1 = t1 / 3, k1b = t1 % 3;
            bf16x8 pf; { const unsigned a0 = pk2(S[t0][0], S[t0][1]), a1 = pk2(S[t0][2], S[t0][3]), a2 = pk2(S[t1][0], S[t1][1]), a3 = pk2(S[t1][2], S[t1][3]);
                const u32x4 pw = (u32x4){a0, a1, a2, a3}; pf = __builtin_bit_cast(bf16x8, pw); }
            LAS const unsigned char* v0 = lds + hsel * HS + ((((rs + i0) & 7) * 64) + 16 * (kb0 + k0b) + 4 * fg + tq) * SVN + (4 * tp) * 2;
            LAS const unsigned char* v1 = lds + hsel * HS + ((((rs + i1) & 7) * 64) + 16 * (kb0 + k1b) + 4 * fg + tq) * SVN + (4 * tp) * 2;
#pragma unroll
            for (int db = 0; db < 4; ++db) { const bf16x8 vf = tr8(v0 + db * 32, v1 + db * 32); o[db] = MFMA16(vf, pf, o[db]); }
        }
        const float inv = 1.f / l;
#pragma unroll
        for (int db = 0; db < 4; ++db) { u32x2 ov; ov.x = pk2(o[db][0] * inv, o[db][1] * inv); ov.y = pk2(o[db][2] * inv, o[db][3] * inv);
            *(u32x2*)(qp + 16 * db + 4 * fg) = ov; }
        __syncthreads();
        if (slide) {
#pragma unroll
            for (int j = 0; j < 2; ++j) { const int pid = tid + 512 * j, ch = pid & 7, hs = (pid >> 3) & 1, c = (pid >> 4) & 63;
                *(LAS u32x4*)(lds + hs * HS + ((((rsn + 7) & 7) * 64) + c) * SVN + ch * 16) = nv[j]; }
        }
        __syncthreads();
        rs = rsn;
    }
}

namespace na2 {
constexpr int RB = 9 * 64 * 128, L_K = 0, L_V = RB, L_RPB = 2 * RB, L_END = L_RPB + 465 * 4;
__device__ __forceinline__ int rs_of(int r) { int s = r - 4; return s < 0 ? 0 : (s > 56 ? 56 : s); }
}
static_assert(na2::L_END <= LDS_BYTES - 64, "NA2 LDS map");
__device__ __forceinline__ void na2_item(Frame& F, int item) {
    using namespace na2;
    const int b = item >> 7, h = (item >> 3) & 15, r0 = (item & 7) * 8;
    const int tid = F.tid, lane = F.lane, w = F.wave, fr = lane & 15, fg = lane >> 4, tq = fr >> 2, tp = fr & 3;
    const int qsel = w >> 2, qb = w & 3;
    LAS unsigned char* lds = F.lds;
    bf16* proj = (bf16*)(F.ws + WS0_PROJ);
    const size_t rowbase = (size_t)b * SEQ;
    __syncthreads();
    for (int i = tid; i < 465; i += NTHREADS) *(LAS float*)(lds + L_RPB + 4 * i) = F.rpb[(size_t)h * 465 + i];
    int hi = rs_of(r0 + 1) + 7;
    for (int kr = rs_of(r0); kr <= hi; ++kr) {
        const int slot = kr % 9;
#pragma unroll
        for (int j = 0; j < 2; ++j) { const int pid = tid + 512 * j, kv = pid >> 9, c = (pid >> 3) & 63, ch = pid & 7;
            const u32x4 v = *(const u32x4*)(proj + (rowbase + kr * 64 + c) * LDP0 + (kv ? P0_V : P0_K) + h * 64 + 8 * ch);
            *(LAS u32x4*)(lds + kv * RB + (slot * 64 + c) * 128 + ((ch ^ (c & 7)) << 4)) = v; }
    }
    __syncthreads();
    const int kb0 = qb < 1 ? 0 : (qb > 2 ? 1 : qb - 1);
    const int wq = 16 * qb + fr;
    int cs = wq - 8; cs = cs < 0 ? 0 : (cs > 48 ? 48 : cs);
    const LAS float* rp = (const LAS float*)(lds + L_RPB);
    for (int it2 = 0; it2 < 4; ++it2) {
        const int r = r0 + 2 * it2 + qsel, rs = rs_of(r);
        const int nhi = (it2 < 3) ? rs_of(r0 + 2 * it2 + 3) + 7 : hi, nnew = nhi - hi;
        u32x4 nv[4];
#pragma unroll
        for (int ri = 0; ri < 2; ++ri)
            if (ri < nnew) {
#pragma unroll
                for (int j = 0; j < 2; ++j) { const int pid = tid + 512 * j, kv = pid >> 9, c = (pid >> 3) & 63, ch = pid & 7;
                    nv[ri * 2 + j] = *(const u32x4*)(proj + (rowbase + (hi + 1 + ri) * 64 + c) * LDP0 + (kv ? P0_V : P0_K) + h * 64 + 8 * ch); }
            }
        bf16* qp = proj + (rowbase + r * 64 + wq) * LDP0 + P0_Q + h * 64;
        const bf16x8 q0 = *(const bf16x8*)(qp + 8 * fg), q1 = *(const bf16x8*)(qp + 32 + 8 * fg);
        f32x4 S[24];
#pragma unroll
        for (int i = 0; i < 8; ++i) {
            const int slot = (rs + i) % 9;
#pragma unroll
            for (int kb = 0; kb < 3; ++kb) {
                const int c = 16 * (kb0 + kb) + fr;
                LAS const unsigned char* kp = lds + L_K + (slot * 64 + c) * 128;
                const bf16x8 k0 = *(LAS const bf16x8*)(kp + ((fg ^ (c & 7)) << 4)), k1 = *(LAS const bf16x8*)(kp + (((4 + fg) ^ (c & 7)) << 4));
                f32x4 a = (f32x4){0.f, 0.f, 0.f, 0.f};
                a = MFMA16(k0, q0, a); a = MFMA16(k1, q1, a);
                S[i * 3 + kb] = a;
            }
        }
        float mx = -3.0e38f;
#pragma unroll
        for (int i = 0; i < 8; ++i)
#pragma unroll
            for (int kb = 0; kb < 3; ++kb)
#pragma unroll
                for (int e = 0; e < 4; ++e) {
                    const int kc = 16 * (kb0 + kb) + 4 * fg + e;
                    const bool valid = (kc >= cs) && (kc < cs + 16);
                    const int bi = (rs + i - r + 7) * 31 + (valid ? (kc - wq + 15) : 0);
                    const float s = valid ? S[i * 3 + kb][e] + rp[bi] : -3.0e38f;
                    S[i * 3 + kb][e] = s; mx = fmaxf(mx, s);
                }
        mx = fmaxf(mx, __shfl_xor(mx, 16)); mx = fmaxf(mx, __shfl_xor(mx, 32));
        float l = 0.f;
#pragma unroll
        for (int t = 0; t < 24; ++t)
#pragma unroll
            for (int e = 0; e < 4; ++e) { const float p = __expf(S[t][e] - mx); S[t][e] = p; l += p; }
        l += __shfl_xor(l, 16); l += __shfl_xor(l, 32);
        f32x4 o[4];
#pragma unroll
        for (int db = 0; db < 4; ++db) o[db] = (f32x4){0.f, 0.f, 0.f, 0.f};
#pragma unroll
        for (int u = 0; u < 12; ++u) {
            const int t0 = 2 * u, t1 = 2 * u + 1, i0 = t0 / 3, k0b = t0 % 3, i1 = t1 / 3, k1b = t1 % 3;
            bf16x8 pf; { const u32x4 pw = (u32x4){pk2(S[t0][0], S[t0][1]), pk2(S[t0][2], S[t0][3]), pk2(S[t1][0], S[t1][1]), pk2(S[t1][2], S[t1][3])}; pf = __builtin_bit_cast(bf16x8, pw); }
            const int c0 = 16 * (kb0 + k0b) + 4 * fg + tq, c1 = 16 * (kb0 + k1b) + 4 * fg + tq;
            LAS const unsigned char* v0 = lds + L_V + (((rs + i0) % 9) * 64 + c0) * 128 + 8 * (tp & 1);
            LAS const unsigned char* v1 = lds + L_V + (((rs + i1) % 9) * 64 + c1) * 128 + 8 * (tp & 1);
#pragma unroll
            for (int db = 0; db < 4; ++db) { const bf16x8 vf = tr8(v0 + (((2 * db + (tp >> 1)) ^ (c0 & 7)) << 4), v1 + (((2 * db + (tp >> 1)) ^ (c1 & 7)) << 4)); o[db] = MFMA16(vf, pf, o[db]); }
        }
        const float inv = 1.f / l;
#pragma unroll
        for (int db = 0; db < 4; ++db) { u32x2 ov; ov.x = pk2(o[db][0] * inv, o[db][1] * inv); ov.y = pk2(o[db][2] * inv, o[db][3] * inv);
            *(u32x2*)(qp + 16 * db + 4 * fg) = ov; }
        __syncthreads();
#pragma unroll
        for (int ri = 0; ri < 2; ++ri)
            if (ri < nnew) {
                const int slot = (hi + 1 + ri) % 9;
#pragma unroll
                for (int j = 0; j < 2; ++j) { const int pid = tid + 512 * j, kv = pid >> 9, c = (pid >> 3) & 63, ch = pid & 7;
                    *(LAS u32x4*)(lds + kv * RB + (slot * 64 + c) * 128 + ((ch ^ (c & 7)) << 4)) = nv[ri * 2 + j]; }
            }
        hi = nhi;
        __syncthreads();
    }
}

__device__ __forceinline__ void headstat_phase(Frame& F) {
    const bf16* H = (const bf16*)(F.ws + WS1_H); float* RS = (float*)(F.ws + WS1_RS);
    const int gw = F.vcu * NWAVES + F.wave, NGW = F.G * NWAVES;
    for (int m = gw; m < M; m += NGW) {
        float ss = 0.f;
#pragma unroll
        for (int c = 0; c < 4; ++c) { const u32x4 w = *(const u32x4*)(H + (size_t)m * 2048 + F.lane * 32 + 8 * c);
            const float a0 = bflo(w.x), a1 = bfhi(w.x), a2 = bflo(w.y), a3 = bfhi(w.y), a4 = bflo(w.z), a5 = bfhi(w.z), a6 = bflo(w.w), a7 = bfhi(w.w);
            ss += (a0 * a0 + a1 * a1) + (a2 * a2 + a3 * a3) + (a4 * a4 + a5 * a5) + (a6 * a6 + a7 * a7); }
        ss += __shfl_xor(ss, 1); ss += __shfl_xor(ss, 2); ss += __shfl_xor(ss, 4);
        if ((F.lane & 7) == 0) RS[(size_t)m * 8 + (F.lane >> 3)] = rsqrtf(ss * (1.f / 256.f) + EPS);
    }
}

__global__ void __launch_bounds__(NTHREADS, 2) mega_fwd(Args args) {
    extern __shared__ __attribute__((aligned(16))) unsigned char lds_raw[];
    Frame F;
    F.lds = (LAS unsigned char*)lds_raw;
    F.tid = threadIdx.x; F.lane = F.tid & 63; F.wave = __builtin_amdgcn_readfirstlane(F.tid >> 6);
    F.G = gridDim.x; { const int bx = blockIdx.x; F.vcu = (F.G % 8 == 0) ? (bx % 8) * (F.G / 8) + bx / 8 : bx; }
    F.x = args.in[0]; F.c = args.in[1]; F.ada_w = args.in[2]; F.ada_b = args.in[3]; F.norm_g = args.in[4]; F.mlp_w1 = args.in[5]; F.mlp_w2 = args.in[6];
    F.ab_w_in = args.in[7]; F.conv_w = args.in[8]; F.conv_b = args.in[9]; F.dt_bias = args.in[10]; F.a_log = args.in[11]; F.d_skip = args.in[12]; F.ssd_norm = args.in[13];
    F.rpb = args.in[14]; F.ab_w_out = args.in[15]; F.ml_w_in = args.in[16]; F.gate_b = args.in[17]; F.head_norm = args.in[18]; F.ml_w_out = args.in[19];
    F.out = args.out; F.ws = args.ws; F.tacc = 0;
    unsigned char* ws = args.ws;
    float* mod = (float*)(ws + WS_MOD);
    volatile LAS unsigned* MISC = (volatile LAS unsigned*)(F.lds + LDS_BYTES - 64);
    if (F.tid < 16) MISC[F.tid] = 0u;
    __syncthreads();
    XcdBarrier bar; bar.bar = (unsigned*)(ws + WS_CTL) + 4096; bar.x = 0; bar.st = nullptr;
    if (MK_ONE_LAUNCH) bar = xcd_barrier_post((unsigned*)(ws + WS_CTL) + 4096, MISC + 8);
    const int lo = args.ph_lo, hi = args.ph_hi;
#define IN(k) (lo <= (k) && (k) < hi && phase_begin(F))
#define SEAM(k) do { if (lo <= (k) && (k) + 1 < hi) xcd_barrier(bar); if (PROBE_MASK) { const unsigned long long now_ = __builtin_amdgcn_s_memrealtime(); if ((PROBE_MASK >> (k)) & 1u) t_acc += now_ - t_last; t_last = now_; } } while (0)
    unsigned long long t_acc = 0, t_last = 0;
    if (PROBE_MASK) t_last = __builtin_amdgcn_s_memrealtime();

    if (IN(0)) {
        const TrJob jobs[7] = {
            {F.ab_w_in, 1024, ABIN, 0, 1024, (bf16*)(ws + W0_IN)},
            {F.ab_w_in, 1024, ABIN, 2592, 3072, (bf16*)(ws + W0_IN) + (size_t)1024 * 1024},
            {F.ab_w_in, 1024, ABIN, 1024, 1536, (bf16*)(ws + W0_IN) + (size_t)4096 * 1024},
            {F.ab_w_in, 1024, ABIN, 2560, 32, (bf16*)(ws + W0_DT)},
            {F.ab_w_out, 2048, 1024, 0, 1024, (bf16*)(ws + W0_OUT)},
            {F.mlp_w1, 1024, FF, 0, FF, (bf16*)(ws + W0_W1)},
            {F.mlp_w2, FF, 1024, 0, 1024, (bf16*)(ws + W0_W2)}};
        transpose_jobs(F, jobs);
        __syncthreads();
        mod_phase(F);
    }
    SEAM(0);
    if (IN(1)) rowpass<false, true>(F, F.x, nullptr, nullptr, nullptr, nullptr, F.norm_g + 0, mod + 0, mod + 1024, (bf16*)(ws + WS0_XN));
    SEAM(1);
    if (IN(2)) {
        EpiBf16 E{(bf16*)(ws + WS0_PROJ), LDP0, P0_Q, P0_K, 0.125f};
        gemm_big(F, (const bf16*)(ws + WS0_XN), DM, (const bf16*)(ws + W0_IN), M, LDP0, DM, E);
        EpiDt Ed{(float*)(ws + WS0_DT), F.dt_bias};
        gemm_simple(F, (const bf16*)(ws + WS0_XN), DM, (const bf16*)(ws + W0_DT), M, 32, DM, Ed);
    }
    SEAM(2);
    if (IN(3)) { conv_phase(F); ssd_prescan(F); }
    SEAM(3);
    if (IN(4)) {
#if USE_SSD_CHUNK
        { unsigned long long q0_ = 0; if (PROBE_SUB == 4) q0_ = __builtin_amdgcn_s_memrealtime();
        for (int it = F.vcu; it < 256; it += F.G) ssd_chunk_item(F, it);
        if (PROBE_SUB == 4) { __syncthreads(); F.tacc += __builtin_amdgcn_s_memrealtime() - q0_; } }
#if USE_NA_MFMA
        for (int it = F.vcu; it < 512; it += F.G) na2_item(F, it);
#else
        na_simple(F, blockIdx.x, F.G);
#endif
#else
        if ((int)blockIdx.x < 128) ssd_simple_item(F, blockIdx.x);
        else na_simple(F, blockIdx.x - 128, F.G - 128);
#endif
    }
    SEAM(4);
    if (IN(5)) gate_phase(F);
    SEAM(5);
    if (IN(6)) { EpiBf16 E{(bf16*)(ws + WS0_XN), DM, 0, 0, 1.f};
        gemm_big(F, (const bf16*)(ws + WS0_PROJ), LDP0, (const bf16*)(ws + W0_OUT), M, DM, 2048, E); }
    SEAM(6);
    if (IN(7)) rowpass<true, true>(F, F.x, (const bf16*)(ws + WS0_XN), mod + 2048, F.norm_g + 1024, F.out, F.norm_g + 2048, mod + 3072, mod + 4096, (bf16*)(ws + WS0_XN));
    SEAM(7);
    if (IN(8)) { EpiRelu2 E{(bf16*)(ws + WS0_U), FF}; gemm_big(F, (const bf16*)(ws + WS0_XN), DM, (const bf16*)(ws + W0_W1), M, FF, DM, E); }
    SEAM(8);
    if (IN(9)) { EpiBf16 E{(bf16*)(ws + WS0_MLPOUT), DM, 0, 0, 1.f}; gemm_big(F, (const bf16*)(ws + WS0_U), FF, (const bf16*)(ws + W0_W2), M, DM, FF, E); }
    SEAM(9);
    if (IN(10)) {
        rowpass<true, true>(F, F.out, (const bf16*)(ws + WS0_MLPOUT), mod + 5120, F.norm_g + 3072, F.out, F.norm_g + 4096, mod + 4 * 6144, mod + 4 * 6144 + 1024, (bf16*)(ws + WS1_XN));
        const TrJob jobs[4] = {
            {F.ml_w_in, 1024, MLIN, 0, 4096, (bf16*)(ws + W1_QKV)},
            {F.ml_w_in, 1024, MLIN, 4096, 2048, (bf16*)(ws + W1_O)},
            {F.ml_w_in, 1024, MLIN, 6144, 32, (bf16*)(ws + W1_G)},
            {F.ml_w_out, 2048, 1024, 0, 1024, (bf16*)(ws + W1_OUT)}};
        transpose_jobs(F, jobs);
    }
    SEAM(10);
    if (IN(11)) {
        EpiBf16 E{(bf16*)(ws + WS1_PROJ), LDP1, 0, 1024, 0.08838834764831845f};
        gemm_big(F, (const bf16*)(ws + WS1_XN), DM, (const bf16*)(ws + W1_QKV), M, 4096, DM, E);
        EpiGates Eg{(float*)(ws + WS1_GATES), F.gate_b};
        gemm_simple(F, (const bf16*)(ws + WS1_XN), DM, (const bf16*)(ws + W1_G), M, 32, DM, Eg);
        __syncthreads();
        if (F.vcu < M / 256) mlstm_prescan(F, 2 * F.vcu, 2);
    }
    SEAM(11);
#if USE_MLSTM_CHUNK
    if (IN(12)) { for (int it = F.vcu; it < 256; it += F.G) mlstm_chunk_item(F, it, 0); }
#else
    if (IN(12)) { if ((int)blockIdx.x < 32) mlstm_simple_item(F, blockIdx.x, 0); }
#endif
    SEAM(12);
#if USE_MLSTM_CHUNK
    if (IN(13)) { for (int it = F.vcu; it < 256; it += F.G) mlstm_chunk_item(F, it, 1); }
#else
    if (IN(13)) { if ((int)blockIdx.x < 32) mlstm_simple_item(F, blockIdx.x, 1); }
#endif
    SEAM(13);
    if (IN(14)) headstat_phase(F);
    SEAM(14);
    if (IN(15)) { EpiOGate E{(bf16*)(ws + WS1_H), (const float*)(ws + WS1_RS), F.head_norm};
        gemm_big(F, (const bf16*)(ws + WS1_XN), DM, (const bf16*)(ws + W1_O), M, 2048, DM, E); }
    SEAM(15);
    if (IN(16)) { EpiBf16 E{(bf16*)(ws + WS1_MIX), DM, 0, 0, 1.f}; gemm_big(F, (const bf16*)(ws + WS1_H), 2048, (const bf16*)(ws + W1_OUT), M, DM, 2048, E); }
    SEAM(16);
    if (IN(17)) {
        rowpass<true, true>(F, F.out, (const bf16*)(ws + WS1_MIX), mod + 4 * 6144 + 2048, F.norm_g + 4096 + 1024, F.out, F.norm_g + 4096 + 2048, mod + 4 * 6144 + 3072, mod + 4 * 6144 + 4096, (bf16*)(ws + WS1_XN));
        const TrJob jobs[2] = {
            {F.mlp_w1 + (size_t)1024 * FF, 1024, FF, 0, FF, (bf16*)(ws + W1_W1)},
            {F.mlp_w2 + (size_t)FF * 1024, FF, 1024, 0, 1024, (bf16*)(ws + W1_W2)}};
        transpose_jobs(F, jobs);
    }
    SEAM(17);
    if (IN(18)) { EpiRelu2 E{(bf16*)(ws + WS1_U), FF}; gemm_big(F, (const bf16*)(ws + WS1_XN), DM, (const bf16*)(ws + W1_W1), M, FF, DM, E); }
    SEAM(18);
    if (IN(19)) { EpiBf16 E{(bf16*)(ws + WS1_MLPOUT), DM, 0, 0, 1.f}; gemm_big(F, (const bf16*)(ws + WS1_U), FF, (const bf16*)(ws + W1_W2), M, DM, FF, E); }
    SEAM(19);
    if (IN(20)) rowpass<true, false>(F, F.out, (const bf16*)(ws + WS1_MLPOUT), mod + 4 * 6144 + 5120, F.norm_g + 4096 + 3072, F.out, nullptr, nullptr, nullptr, nullptr);
    if (PROBE_MASK || PROBE_SUB) {
        t_acc += F.tacc;
        const unsigned long long t_end = __builtin_amdgcn_s_memrealtime();
        if ((PROBE_MASK >> (NPHASE - 1)) & 1u) t_acc += t_end - t_last;
        if (blockIdx.x == 0 && threadIdx.x == 0) { const unsigned long long span = t_acc * PROBE_MULT; while (__builtin_amdgcn_s_memrealtime() - t_end < span) __builtin_amdgcn_s_sleep(32); }
    }
#undef IN
#undef SEAM
}

extern "C" void kernel_launch(void* const* d_in, const int* in_sizes, int n_in, void* d_out, int out_size, void* d_ws, size_t ws_size, hipStream_t stream) {
    static int grid = 0;
    if (grid == 0) {
        if (n_in != 20 || out_size != M * DM || ws_size < WS_END) { fprintf(stderr, "kernel_launch: unexpected problem shape (n_in %d out %d ws %zu)\n", n_in, out_size, ws_size); grid = -1; return; }
        int dev = 0, cus = 0;
        if (hipGetDevice(&dev) != hipSuccess || hipDeviceGetAttribute(&cus, hipDeviceAttributeMultiprocessorCount, dev) != hipSuccess) { grid = -1; return; }
        if (hipFuncSetAttribute((const void*)mega_fwd, hipFuncAttributeMaxDynamicSharedMemorySize, LDS_BYTES) != hipSuccess) { fprintf(stderr, "kernel_launch: hipFuncSetAttribute failed\n"); grid = -1; return; }
        int per_cu = 0;
        if (hipOccupancyMaxActiveBlocksPerMultiprocessor(&per_cu, (const void*)mega_fwd, NTHREADS, LDS_BYTES) != hipSuccess || per_cu < 1) fprintf(stderr, "kernel_launch: occupancy query says %d\n", per_cu);
        (void)hipGetLastError();
        grid = cus;
    }
    if (grid < 0) return;
    (void)hipMemsetAsync((char*)d_ws + WS_CTL, 0, CTL_ZERO_BYTES, stream);
    Args a{};
    for (int i = 0; i < 20; ++i) a.in[i] = (const float*)d_in[i];
    a.out = (float*)d_out; a.ws = (unsigned char*)d_ws;
#if MK_ONE_LAUNCH
    a.ph_lo = 0; a.ph_hi = NPHASE;
    hipLaunchKernelGGL(mega_fwd, dim3(grid), dim3(NTHREADS), LDS_BYTES, stream, a);
#else
    for (int p = 0; p < NPHASE; ++p) { a.ph_lo = p; a.ph_hi = p + 1; hipLaunchKernelGGL(mega_fwd, dim3(grid), dim3(NTHREADS), LDS_BYTES, stream, a); }
#endif
}
```
